# Optimizing an MI355X kernel written in HIP

```python
import math
import jax
import jax.numpy as jnp
from jax import lax
import numpy as np

D_MODEL = 1024
BATCH = 4
SEQ = 4096
DEPTH = 2
DEC_BATCH = 16
DEC_SEQ = 32
PAST_LEN = 2048

CHUNK = 64
N_MIXERS = 2
N_DIFF_LAYERS = (DEPTH + 1) // 2
N_RET_LAYERS = DEPTH // 2
DA_HEADS = 4
DA_HEAD_DIM = D_MODEL // (2 * DA_HEADS)
DA_QBLOCK = 128
DA_SUBLN_EPS = 1e-5
RET_HEADS = 4
RET_DK = D_MODEL // RET_HEADS
RET_DV = 2 * RET_DK
RET_GN_EPS = 1e-6
ROPE_BASE = 10000.0
D_FF = 2816
NORM_EPS = 1e-6
NEG_INF = -1e30

kernel_name = "chunk_streaming_diffattn_retention_macaron"


def rmsnorm(x, g, eps=NORM_EPS):
    xf = x.astype(jnp.float32)
    y = xf * lax.rsqrt(jnp.mean(xf * xf, axis=-1, keepdims=True) + eps)
    return (y * g.astype(jnp.float32)).astype(x.dtype)


def swiglu_half(x, g, w_gate, w_up, w_down):
    h = rmsnorm(x, g)
    u = jax.nn.silu(h @ w_gate) * (h @ w_up)
    return x + 0.5 * (u @ w_down)


def lambda_init(layer_idx):
    return 0.8 - 0.6 * math.exp(-0.3 * layer_idx)


def diff_attn_project(h, w_qkv):
    B, T, _ = h.shape
    q, k, v = jnp.split(h @ w_qkv, 3, axis=-1)
    q = q.reshape(B, T, DA_HEADS, 2, DA_HEAD_DIM)
    k = k.reshape(B, T, DA_HEADS, 2, DA_HEAD_DIM)
    v = v.reshape(B, T, DA_HEADS, 2 * DA_HEAD_DIM)
    return q, k, v


def diff_attn_block(q, k, v, q_pos, k_pos, lam):
    s = jnp.einsum('bqhcd,bkhcd->bhcqk', q.astype(jnp.float32), k.astype(jnp.float32)) * (DA_HEAD_DIM ** -0.5)
    mask = (k_pos[None, :] // CHUNK) <= (q_pos[:, None] // CHUNK)
    s = jnp.where(mask[None, None, None], s, NEG_INF)
    p = jax.nn.softmax(s, axis=-1)
    a = p[:, :, 0] - lam * p[:, :, 1]
    return jnp.einsum('bhqk,bkhe->bqhe', a, v.astype(jnp.float32))


def diff_attn_prompt(q, k, v, lam):
    B, T = q.shape[0], q.shape[1]
    nb = T // DA_QBLOCK
    qb = jnp.moveaxis(q.reshape(B, nb, DA_QBLOCK, DA_HEADS, 2, DA_HEAD_DIM), 1, 0)
    posb = jnp.arange(T, dtype=jnp.int32).reshape(nb, DA_QBLOCK)
    k_pos = jnp.arange(T, dtype=jnp.int32)
    o = lax.map(lambda args: diff_attn_block(args[0], k, v, args[1], k_pos, lam), (qb, posb))
    return jnp.moveaxis(o, 0, 1).reshape(B, T, DA_HEADS, 2 * DA_HEAD_DIM)


def diff_attn_out(o, lam_init, subln, w_o):
    B, T = o.shape[0], o.shape[1]
    o = rmsnorm(o, subln, DA_SUBLN_EPS) * (1.0 - lam_init)
    return o.reshape(B, T, DA_HEADS * 2 * DA_HEAD_DIM).astype(w_o.dtype) @ w_o


def rotary(x, pos):
    dk = x.shape[-1]
    angle = 1.0 / (ROPE_BASE ** jnp.linspace(0.0, 1.0, dk // 2, dtype=jnp.float32))
    angle = jnp.repeat(angle, 2)
    theta = pos[:, None] * angle[None, :]
    sin = jnp.sin(theta)[None, :, None, :]
    cos = jnp.cos(theta)[None, :, None, :]
    x1 = x[..., 0::2]
    x2 = x[..., 1::2]
    rot = jnp.stack((-x2, x1), axis=-1).reshape(x.shape)
    return x * cos + rot * sin


def ret_log_decay():
    return jnp.log1p(-jnp.exp2(-5.0 - jnp.arange(RET_HEADS, dtype=jnp.float32)))


def ret_project(h, w_in, pos):
    B, T, _ = h.shape
    nq = RET_HEADS * RET_DK
    nv = RET_HEADS * RET_DV
    proj = h @ w_in
    q, k, v, g = jnp.split(proj, [nq, 2 * nq, 2 * nq + nv], axis=-1)
    q = rotary(q.reshape(B, T, RET_HEADS, RET_DK).astype(jnp.float32), pos)
    k = rotary(k.reshape(B, T, RET_HEADS, RET_DK).astype(jnp.float32), pos) * (RET_DK ** -0.5)
    v = v.reshape(B, T, RET_HEADS, RET_DV).astype(jnp.float32)
    return q, k, v, g


def retention_chunk(S, q, k, v):
    L = q.shape[1]
    lg = ret_log_decay()
    idx = jnp.arange(L, dtype=jnp.float32)
    rel = idx[:, None] - idx[None, :]
    dmask = jnp.where(rel[None] >= 0, jnp.exp(jnp.maximum(rel, 0.0)[None] * lg[:, None, None]), 0.0)
    qk = jnp.einsum('bihd,bjhd->bhij', q, k) * dmask[None]
    inner = jnp.einsum('bhij,bjhe->bihe', qk, v)
    cross = jnp.einsum('bihd,bhde->bihe', q, S) * jnp.exp((idx + 1.0)[:, None] * lg[None, :])[None, :, :, None]
    kd = k * jnp.exp((L - 1.0 - idx)[:, None] * lg[None, :])[None, :, :, None]
    S_new = S * jnp.exp(L * lg)[None, :, None, None] + jnp.einsum('bjhd,bjhe->bhde', kd, v)
    return S_new, inner + cross


def retention_prompt(q, k, v):
    B, T = q.shape[0], q.shape[1]
    nc = T // CHUNK

    def to_chunks(a):
        return jnp.moveaxis(a.reshape(B, nc, CHUNK, *a.shape[2:]), 1, 0)

    S0 = jnp.zeros((B, RET_HEADS, RET_DK, RET_DV), jnp.float32)
    S_fin, o = lax.scan(lambda S, c: retention_chunk(S, c[0], c[1], c[2]), S0,
                        (to_chunks(q), to_chunks(k), to_chunks(v)))
    return S_fin, jnp.moveaxis(o, 0, 1).reshape(B, T, RET_HEADS, RET_DV)


def ret_out(o, g, w_o):
    B, T = o.shape[0], o.shape[1]
    on = o * lax.rsqrt(jnp.mean(o * o, axis=-1, keepdims=True) + RET_GN_EPS)
    y = jax.nn.silu(g.astype(jnp.float32)) * on.reshape(B, T, RET_HEADS * RET_DV)
    return y.astype(w_o.dtype) @ w_o


def setup_inputs(seed: int = 0) -> dict:
    key = jax.random.key(seed)
    ks = jax.random.split(key, 32)
    f32 = jnp.float32

    def nrm(k, shape, scale):
        return jax.random.normal(k, shape, f32) * scale

    def gain(k, shape):
        return 1.0 + 0.01 * jax.random.normal(k, shape, f32)

    D = D_MODEL
    return {
        "x_prompt": nrm(ks[0], (BATCH, SEQ, D), 1.0),
        "x_sample": nrm(ks[1], (DEC_BATCH, DEC_SEQ, D), 1.0),
        "cache_diff_k": nrm(ks[2], (N_DIFF_LAYERS, DEC_BATCH, PAST_LEN, DA_HEADS, 2, DA_HEAD_DIM), 1.0),
        "cache_diff_v": nrm(ks[3], (N_DIFF_LAYERS, DEC_BATCH, PAST_LEN, DA_HEADS, 2 * DA_HEAD_DIM), 1.0),
        "state_ret": nrm(ks[4], (N_RET_LAYERS, DEC_BATCH, RET_HEADS, RET_DK, RET_DV), 0.3),
        "ffn1_norm": gain(ks[5], (DEPTH, D)),
        "ffn1_w_gate": nrm(ks[6], (DEPTH, D, D_FF), D ** -0.5),
        "ffn1_w_up": nrm(ks[7], (DEPTH, D, D_FF), D ** -0.5),
        "ffn1_w_down": nrm(ks[8], (DEPTH, D_FF, D), D_FF ** -0.5),
        "mix_norm": gain(ks[9], (DEPTH, D)),
        "da_w_qkv": nrm(ks[10], (N_DIFF_LAYERS, D, 3 * D), D ** -0.5),
        "da_lambda_q1": nrm(ks[11], (N_DIFF_LAYERS, DA_HEAD_DIM), 0.1),
        "da_lambda_k1": nrm(ks[12], (N_DIFF_LAYERS, DA_HEAD_DIM), 0.1),
        "da_lambda_q2": nrm(ks[13], (N_DIFF_LAYERS, DA_HEAD_DIM), 0.1),
        "da_lambda_k2": nrm(ks[14], (N_DIFF_LAYERS, DA_HEAD_DIM), 0.1),
        "da_subln": gain(ks[15], (N_DIFF_LAYERS, 2 * DA_HEAD_DIM)),
        "da_w_o": nrm(ks[16], (N_DIFF_LAYERS, D, D), D ** -0.5),
        "ret_w_in": nrm(ks[17], (N_RET_LAYERS, D, 2 * RET_HEADS * RET_DK + 2 * RET_HEADS * RET_DV), D ** -0.5),
        "ret_w_o": nrm(ks[18], (N_RET_LAYERS, RET_HEADS * RET_DV, D), (RET_HEADS * RET_DV) ** -0.5),
        "ffn2_norm": gain(ks[19], (DEPTH, D)),
        "ffn2_w_gate": nrm(ks[20], (DEPTH, D, D_FF), D ** -0.5),
        "ffn2_w_up": nrm(ks[21], (DEPTH, D, D_FF), D ** -0.5),
        "ffn2_w_down": nrm(ks[22], (DEPTH, D_FF, D), D_FF ** -0.5),
        "final_norm": gain(ks[23], (D,)),
    }


def reference(x_prompt, x_sample, cache_diff_k, cache_diff_v, state_ret,
              ffn1_norm, ffn1_w_gate, ffn1_w_up, ffn1_w_down, mix_norm,
              da_w_qkv, da_lambda_q1, da_lambda_k1, da_lambda_q2, da_lambda_k2, da_subln, da_w_o,
              ret_w_in, ret_w_o,
              ffn2_norm, ffn2_w_gate, ffn2_w_up, ffn2_w_down, final_norm):
    f32 = jnp.float32
    t_p = x_prompt.shape[1]
    t_s = x_sample.shape[1]
    past = cache_diff_k.shape[2]
    pos_p = jnp.arange(t_p, dtype=f32)
    pos_s = past + jnp.arange(t_s, dtype=f32)

    xp, xs = x_prompt, x_sample
    kp_list, vp_list, sp_list = [], [], []
    ks_list, vs_list, ss_list = [], [], []
    for i in range(DEPTH):
        xp = swiglu_half(xp, ffn1_norm[i], ffn1_w_gate[i], ffn1_w_up[i], ffn1_w_down[i])
        xs = swiglu_half(xs, ffn1_norm[i], ffn1_w_gate[i], ffn1_w_up[i], ffn1_w_down[i])
        hp = rmsnorm(xp, mix_norm[i])
        hs = rmsnorm(xs, mix_norm[i])
        if i % N_MIXERS == 0:
            a = i // N_MIXERS
            lam_i = lambda_init(i)
            lam = (jnp.exp(jnp.sum(da_lambda_q1[a].astype(f32) * da_lambda_k1[a].astype(f32)))
                   - jnp.exp(jnp.sum(da_lambda_q2[a].astype(f32) * da_lambda_k2[a].astype(f32))) + lam_i)
            qp, kp, vp = diff_attn_project(hp, da_w_qkv[a])
            op = diff_attn_prompt(qp, kp, vp, lam)
            qs, ks, vs = diff_attn_project(hs, da_w_qkv[a])
            k_all = jnp.concatenate([cache_diff_k[a], ks.astype(cache_diff_k.dtype)], axis=1)
            v_all = jnp.concatenate([cache_diff_v[a], vs.astype(cache_diff_v.dtype)], axis=1)
            k_pos = jnp.arange(past + t_s, dtype=jnp.int32)
            q_pos = past + jnp.arange(t_s, dtype=jnp.int32)
            os_ = diff_attn_block(qs, k_all, v_all, q_pos, k_pos, lam)
            xp = xp + diff_attn_out(op, lam_i, da_subln[a], da_w_o[a]).astype(xp.dtype)
            xs = xs + diff_attn_out(os_, lam_i, da_subln[a], da_w_o[a]).astype(xs.dtype)
            kp_list.append(kp)
            vp_list.append(vp)
            ks_list.append(ks)
            vs_list.append(vs)
        else:
            r = i // N_MIXERS
            qp, kp, vp, gp = ret_project(hp, ret_w_in[r], pos_p)
            sp, op = retention_prompt(qp, kp, vp)
            qs, ks, vs, gs = ret_project(hs, ret_w_in[r], pos_s)
            ss, os_ = retention_chunk(state_ret[r].astype(f32), qs, ks, vs)
            xp = xp + ret_out(op, gp, ret_w_o[r]).astype(xp.dtype)
            xs = xs + ret_out(os_, gs, ret_w_o[r]).astype(xs.dtype)
            sp_list.append(sp)
            ss_list.append(ss)
        xp = swiglu_half(xp, ffn2_norm[i], ffn2_w_gate[i], ffn2_w_up[i], ffn2_w_down[i])
        xs = swiglu_half(xs, ffn2_norm[i], ffn2_w_gate[i], ffn2_w_up[i], ffn2_w_down[i])

    y_prompt = rmsnorm(xp, final_norm)
    y_sample = rmsnorm(xs, final_norm)
    return (y_prompt, y_sample,
            jnp.stack(kp_list), jnp.stack(vp_list), jnp.stack(sp_list),
            jnp.stack(ks_list), jnp.stack(vs_list), jnp.stack(ss_list))
```

```cpp
#include <hip/hip_runtime.h>
#include <hip/hip_cooperative_groups.h>
#include <cstdio>
namespace cg = cooperative_groups;

#define LAS __attribute__((address_space(3)))
typedef unsigned short bf16_t;
typedef short bf16x8 __attribute__((ext_vector_type(8)));
typedef short s16x4 __attribute__((ext_vector_type(4)));
typedef float f32x4 __attribute__((ext_vector_type(4)));
typedef unsigned u32x4 __attribute__((ext_vector_type(4)));
typedef unsigned u32x2 __attribute__((ext_vector_type(2)));
typedef unsigned long long u64;
#define SS_FX 1048576.0f
#define SS_INV (1.0f / 1048576.0f)

constexpr int D = 1024, DFF = 2816, MP = 16384, MS = 512, MT = MP + MS;
constexpr int SEQ = 4096, PAST = 2048, DSEQ = 32;
constexpr int NTHREADS = 512;
constexpr int LDS_BYTES = 131072 + 256 + 8192;
constexpr int LDS_MISC = 131072;
constexpr int LDS_RTAB = 131072 + 256;

constexpr size_t WS_CTL = 0;
constexpr size_t WS_SS = 4096;
constexpr size_t WS_RSS = WS_SS + 7ull * MT * 4;
constexpr size_t WS_WGU = 1ull << 20;
constexpr size_t WGU_BYTES = 5632ull * 1024 * 2;
constexpr size_t WS_WD = WS_WGU + 4 * WGU_BYTES;
constexpr size_t WD_BYTES = 1024ull * 2816 * 2;
constexpr size_t WS_WQKV = WS_WD + 4 * WD_BYTES;
constexpr size_t WS_WO = WS_WQKV + 3072ull * 1024 * 2;
constexpr size_t WS_WRIN = WS_WO + 1024ull * 1024 * 2;
constexpr size_t WS_WRO = WS_WRIN + 6144ull * 1024 * 2;
constexpr size_t WS_X = WS_WRO + 1024ull * 2048 * 2;
constexpr size_t WS_XB = WS_X + (size_t)MT * D * 4;
constexpr size_t WS_SCR = WS_XB + (size_t)MT * D * 2;
constexpr size_t ACT1 = (size_t)MT * D * 2;
constexpr size_t WS_END = WS_SCR + 6 * ACT1;
constexpr size_t WS_PG = WS_WGU + WGU_BYTES;
constexpr size_t WS_RSSP = WS_WGU;
static_assert(1088ull * 8192 <= WGU_BYTES && (size_t)MT * 4 * 32 * 4 <= WGU_BYTES, "aliased regions");

struct Params {
    const float* in[24];
    float* out;
    unsigned char* ws;
};

#define LDS_BARRIER() do { asm volatile("s_waitcnt lgkmcnt(0)" ::: "memory"); __builtin_amdgcn_s_barrier(); asm volatile("" ::: "memory"); } while (0)
__device__ __forceinline__ unsigned cvt_pk_bf16(float lo, float hi) { unsigned r; asm("v_cvt_pk_bf16_f32 %0, %1, %2" : "=v"(r) : "v"(lo), "v"(hi)); return r; }
__device__ __forceinline__ float bf16lo(unsigned u) { return __uint_as_float(u << 16); }
__device__ __forceinline__ float bf16hi(unsigned u) { return __uint_as_float(u & 0xffff0000u); }
__device__ __forceinline__ float fast_exp2(float x) { return __builtin_amdgcn_exp2f(x); }
__device__ __forceinline__ float fast_rcp(float x) { return __builtin_amdgcn_rcpf(x); }
__device__ __forceinline__ float silu_f(float x) { return x * fast_rcp(1.0f + fast_exp2(-1.44269504089f * x)); }
__device__ __forceinline__ u32x4 pack8(f32x4 a, f32x4 b) { u32x4 w; w.x = cvt_pk_bf16(a[0], a[1]); w.y = cvt_pk_bf16(a[2], a[3]); w.z = cvt_pk_bf16(b[0], b[1]); w.w = cvt_pk_bf16(b[2], b[3]); return w; }
__device__ __forceinline__ f32x4 mfma16(bf16x8 a, bf16x8 b, f32x4 c) { return __builtin_amdgcn_mfma_f32_16x16x32_bf16(a, b, c, 0, 0, 0); }
__device__ __forceinline__ s16x4 tr_read(LAS unsigned char* p) { return __builtin_amdgcn_ds_read_tr16_b64_v4i16((LAS s16x4*)p); }
__device__ __forceinline__ bf16x8 cat8(s16x4 a, s16x4 b) { bf16x8 r = {a[0], a[1], a[2], a[3], b[0], b[1], b[2], b[3]}; return r; }
__device__ __forceinline__ bf16x8 as_bf16x8(u32x4 v) { union { u32x4 u; bf16x8 s; } x; x.u = v; return x.s; }

namespace pg8 {
constexpr int BM = 256, BK = 64, HALF = 128, HTB = HALF * BK * 2, STAGE_BYTES = 8 * HTB, NXCD = 8, WGM = 8;
__host__ __device__ __forceinline__ int lds_byte(int r, int c) { const int st = (r >> 4) * 2 + (c >> 5), rr = r & 15, cc = c & 31, ob = rr * 64 + cc * 2; return st * 1024 + (ob ^ (((ob >> 9) & 1) << 5)); }
__host__ __device__ __forceinline__ void stage_rc(int b, int& R, int& C) { const int st = b / 1024, sb = b % 1024, swz = sb ^ (((sb >> 9) & 1) << 5); R = (st >> 1) * 16 + swz / 64; C = (st & 1) * 32 + (swz % 64) / 2; }
__host__ __device__ __forceinline__ int perm32(int rho) { const int n = rho >> 4, i = rho & 15; return 8 * (i >> 2) + 4 * n + (i & 3); }
struct Unit { int pm, pn; };
struct Gemm { const bf16_t* A; const bf16_t* Bt; int M, N, K; };
struct StaticOrder {
    int nM, nN, nwg, G, c;
    __device__ void init(int M, int N, int G_, int c_) { nM = M / BM; nN = N / BM; nwg = nM * nN; G = G_; c = c_; }
    __device__ bool next(int i, Unit& u) const {
        const long L = (long)i * G + c; if (L >= nwg) return false;
        int wgid = (int)L; { const int q = nwg / NXCD, r = nwg % NXCD, xcd = wgid % NXCD, off = wgid / NXCD; wgid = (xcd < r ? xcd * (q + 1) : r * (q + 1) + (xcd - r) * q) + off; }
        const int nig = WGM * nN, gid = wgid / nig, fm = gid * WGM, gsz = (nM - fm) < WGM ? (nM - fm) : WGM;
        u.pm = fm + ((wgid % nig) % gsz); u.pn = (wgid % nig) / gsz; return true;
    }
};
template <class Epi>
__device__ __forceinline__ void gemm_phase(LAS unsigned char* lds, const Gemm g, const StaticOrder& S, const Epi& E) {
    int tid_ = threadIdx.x; asm volatile("" : "+v"(tid_));
    const int tid = tid_, wid = __builtin_amdgcn_readfirstlane(tid >> 6), lane = tid & 63, wr = wid >> 2, wc = wid & 3, fr = lane & 15, fq = lane >> 4;
    const int K = g.K, nt = K / BK;
    unsigned voffA[2], voffB[2];
#pragma unroll
    for (int i = 0; i < 2; ++i) { int R, C; stage_rc(tid * 16 + i * 8192, R, C); const int Rb = (R & ~31) + perm32(R & 31);
        voffA[i] = (unsigned)(R * K + C) * 2u; voffB[i] = (unsigned)(Rb * K + C) * 2u; }
    const size_t kstep = (size_t)(BK * 2);
    const size_t hstep = (size_t)HALF * K * 2;
    const size_t tstep = 2 * hstep;
    const unsigned ldsw = (unsigned)wid * 1024u;
    const int aoff = lds_byte(wr * 64 + fr, fq * 8), boff = lds_byte(wc * 32 + fr, fq * 8);
#define PG8_SA(b, h) (((b) * 2 + (h)) * HTB)
#define PG8_SB(b, h) ((4 + (b) * 2 + (h)) * HTB)
#define PG8_STAGE(bufoff, gbase, voff) do { _Pragma("unroll") for (int _i = 0; _i < 2; ++_i) \
        __builtin_amdgcn_global_load_lds((const unsigned*)((const char*)(gbase) + (voff)[_i]), (LAS unsigned*)(lds + (bufoff) + ldsw + _i * 8192), 16, 0, 0); } while (0)
#define PG8_LDA(dst, b, h) do { _Pragma("unroll") for (int m = 0; m < 4; ++m) _Pragma("unroll") for (int k = 0; k < 2; ++k) dst[m][k] = *(const LAS bf16x8*)(lds + PG8_SA(b, h) + aoff + m * 2048 + k * 1024); } while (0)
#define PG8_LDB(dst, b, h) do { _Pragma("unroll") for (int n = 0; n < 2; ++n) _Pragma("unroll") for (int k = 0; k < 2; ++k) dst[n][k] = *(const LAS bf16x8*)(lds + PG8_SB(b, h) + boff + n * 2048 + k * 1024); } while (0)
#define PG8_MMA(ai, bj, At, Bt) do { __builtin_amdgcn_s_setprio(1); _Pragma("unroll") for (int m = 0; m < 4; ++m) _Pragma("unroll") for (int n = 0; n < 2; ++n) _Pragma("unroll") for (int k = 0; k < 2; ++k) \
        acc[ai][bj][m][n] = __builtin_amdgcn_mfma_f32_16x16x32_bf16(Bt[n][k], At[m][k], acc[ai][bj][m][n], 0, 0, 0); __builtin_amdgcn_s_setprio(0); } while (0)
#define PG8_WAIT_V(n) asm volatile("s_waitcnt vmcnt(" #n ")" ::: "memory")
#define PG8_WAIT_L(n) asm volatile("s_waitcnt lgkmcnt(" #n ")" ::: "memory")
#define PG8_BAR __builtin_amdgcn_s_barrier()
#define PG8_SCHED __builtin_amdgcn_sched_barrier(0)
    Unit cur, nxt; int ui = 0;
    if (!S.next(0, cur)) return;
    f32x4 acc[2][2][4][2];
#pragma unroll
    for (int a = 0; a < 2; ++a)
#pragma unroll
        for (int b = 0; b < 2; ++b)
#pragma unroll
            for (int m = 0; m < 4; ++m)
#pragma unroll
                for (int n = 0; n < 2; ++n) acc[a][b][m][n] = (f32x4){0.f, 0.f, 0.f, 0.f};
    bf16x8 At[4][2], B0[2][2], B1[2][2];
    const char* cA = (const char*)g.A + (size_t)cur.pm * tstep; const char* cB = (const char*)g.Bt + (size_t)cur.pn * tstep;
    PG8_STAGE(PG8_SB(0, 0), cB, voffB); PG8_STAGE(PG8_SA(0, 0), cA, voffA); PG8_STAGE(PG8_SB(0, 1), cB + hstep, voffB); PG8_STAGE(PG8_SA(0, 1), cA + hstep, voffA);
    if (wr == 1) PG8_BAR;
    PG8_WAIT_V(4); PG8_BAR;
    PG8_STAGE(PG8_SB(1, 0), cB + kstep, voffB); PG8_STAGE(PG8_SA(1, 0), cA + kstep, voffA); PG8_STAGE(PG8_SB(1, 1), cB + hstep + kstep, voffB);
    PG8_WAIT_V(6); PG8_BAR;
    for (;;) {
        const bool has_next = S.next(ui + 1, nxt);
        const char* nA = has_next ? (const char*)g.A + (size_t)nxt.pm * tstep : cA; const char* nB = has_next ? (const char*)g.Bt + (size_t)nxt.pn * tstep : cB;
        for (int t = 0; t < nt; t += 2) {
            const bool last = (t == nt - 2);
            const char* a1 = cA + (size_t)(t + 1) * kstep;
            const char* a2 = last ? nA : cA + (size_t)(t + 2) * kstep; const char* b2 = last ? nB : cB + (size_t)(t + 2) * kstep;
            const char* a3 = a2 + kstep; const char* b3 = b2 + kstep;
            PG8_LDB(B0, 0, 0); PG8_SCHED; PG8_LDA(At, 0, 0); PG8_STAGE(PG8_SA(1, 1), a1 + hstep, voffA);
            PG8_WAIT_L(8); PG8_BAR; PG8_WAIT_L(0); PG8_MMA(0, 0, At, B0); PG8_BAR; PG8_SCHED;
            PG8_LDB(B1, 0, 1); PG8_STAGE(PG8_SB(0, 0), b2, voffB);
            PG8_BAR; PG8_WAIT_L(0); PG8_MMA(0, 1, At, B1); PG8_BAR;
            PG8_LDA(At, 0, 1); PG8_STAGE(PG8_SA(0, 0), a2, voffA);
            PG8_BAR; PG8_WAIT_L(0); PG8_MMA(1, 0, At, B0); PG8_BAR; PG8_SCHED;
            PG8_STAGE(PG8_SB(0, 1), b2 + hstep, voffB);
            PG8_WAIT_V(6); PG8_BAR; PG8_MMA(1, 1, At, B1); PG8_BAR;
            PG8_LDB(B0, 1, 0); PG8_SCHED; PG8_LDA(At, 1, 0); PG8_STAGE(PG8_SA(0, 1), a2 + hstep, voffA);
            PG8_WAIT_L(8); PG8_BAR; PG8_WAIT_L(0); PG8_MMA(0, 0, At, B0); PG8_BAR; PG8_SCHED;
            PG8_LDB(B1, 1, 1); PG8_STAGE(PG8_SB(1, 0), b3, voffB);
            PG8_BAR; PG8_WAIT_L(0); PG8_MMA(0, 1, At, B1); PG8_BAR;
            PG8_LDA(At, 1, 1); PG8_STAGE(PG8_SA(1, 0), a3, voffA);
            PG8_BAR; PG8_WAIT_L(0); PG8_MMA(1, 0, At, B0); PG8_BAR; PG8_SCHED;
            PG8_STAGE(PG8_SB(1, 1), b3 + hstep, voffB);
            PG8_WAIT_V(6); PG8_BAR; PG8_MMA(1, 1, At, B1); PG8_BAR;
        }
        E(acc, cur, wr, wc, fr, fq, ui);
        if (!has_next) break;
#pragma unroll
        for (int a = 0; a < 2; ++a)
#pragma unroll
            for (int b = 0; b < 2; ++b)
#pragma unroll
                for (int m = 0; m < 4; ++m)
#pragma unroll
                    for (int n = 0; n < 2; ++n) acc[a][b][m][n] = (f32x4){0.f, 0.f, 0.f, 0.f};
        cur = nxt; cA = nA; cB = nB; ++ui;
    }
    PG8_WAIT_V(0);
    if (wr == 0) PG8_BAR;
    PG8_BAR;
#undef PG8_SA
#undef PG8_SB
#undef PG8_STAGE
#undef PG8_LDA
#undef PG8_LDB
#undef PG8_MMA
#undef PG8_WAIT_V
#undef PG8_WAIT_L
#undef PG8_BAR
#undef PG8_SCHED
}
}

typedef f32x4 Acc[2][2][4][2];
struct EpiGU {
    const LAS float* rtab; bf16_t* H;
    __device__ __forceinline__ void operator()(const Acc& acc, const pg8::Unit& u, int wr, int wc, int fr, int fq, int ui) const {
        const int row0 = u.pm * 256 + wr * 64 + fr, col0 = u.pn * 128 + wc * 32 + 8 * fq;
#pragma unroll
        for (int ai = 0; ai < 2; ++ai)
#pragma unroll
            for (int m = 0; m < 4; ++m) {
                const int row = row0 + ai * 128 + m * 16;
                const float r = rtab[(ui & 7) * 256 + (row & 255)];
                f32x4 h0, h1;
#pragma unroll
                for (int j = 0; j < 4; ++j) { h0[j] = silu_f(acc[ai][0][m][0][j] * r) * (acc[ai][1][m][0][j] * r); h1[j] = silu_f(acc[ai][0][m][1][j] * r) * (acc[ai][1][m][1][j] * r); }
                *(u32x4*)(H + (size_t)row * DFF + col0) = pack8(h0, h1);
            }
    }
};
struct EpiRes {
    bf16_t* XB; u64* ssout; float alpha;
    __device__ __forceinline__ void operator()(const Acc& acc, const pg8::Unit& u, int wr, int wc, int fr, int fq, int ui) const {
        const int row0 = u.pm * 256 + wr * 64 + fr, col0 = u.pn * 256 + wc * 32 + 8 * fq;
        u32x4 xv[2][4][2];
#pragma unroll
        for (int ai = 0; ai < 2; ++ai)
#pragma unroll
            for (int m = 0; m < 4; ++m)
#pragma unroll
                for (int bj = 0; bj < 2; ++bj) xv[ai][m][bj] = *(const u32x4*)(XB + (size_t)(row0 + ai * 128 + m * 16) * D + col0 + bj * 128);
#pragma unroll
        for (int ai = 0; ai < 2; ++ai)
#pragma unroll
            for (int m = 0; m < 4; ++m) {
                const int row = row0 + ai * 128 + m * 16;
                float sq = 0.f;
#pragma unroll
                for (int bj = 0; bj < 2; ++bj) {
                    bf16_t* xp = XB + (size_t)row * D + col0 + bj * 128;
                    const u32x4 xb = xv[ai][m][bj];
                    f32x4 x0 = (f32x4){bf16lo(xb.x), bf16hi(xb.x), bf16lo(xb.y), bf16hi(xb.y)}, x1 = (f32x4){bf16lo(xb.z), bf16hi(xb.z), bf16lo(xb.w), bf16hi(xb.w)};
                    x0 += alpha * acc[ai][bj][m][0]; x1 += alpha * acc[ai][bj][m][1];
                    *(u32x4*)xp = pack8(x0, x1);
                    sq += x0[0] * x0[0] + x0[1] * x0[1] + x0[2] * x0[2] + x0[3] * x0[3] + x1[0] * x1[0] + x1[1] * x1[1] + x1[2] * x1[2] + x1[3] * x1[3];
                }
                sq += __shfl_xor(sq, 16); sq += __shfl_xor(sq, 32);
                if (fq == 0) atomicAdd(ssout + row, (u64)(sq * SS_FX));
            }
    }
};
struct EpiQKV {
    const LAS float* rtab; bf16_t* Qb; float* out;
    __device__ __forceinline__ void operator()(const Acc& acc, const pg8::Unit& u, int wr, int wc, int fr, int fq, int ui) const {
        const int t = u.pn >> 2;
        const int row0 = u.pm * 256 + wr * 64 + fr, col0 = (u.pn & 3) * 256 + wc * 32 + 8 * fq;
        const float qs = 0.08838834764831845f * 1.44269504089f;
        bf16_t* bdst = Qb + (size_t)t * MT * D;
        const size_t foff = u.pm < 64 ? (size_t)17301504 + (size_t)(t - 1) * 16777216 : (size_t)52953088 + (size_t)(t - 1) * 524288;
        float* fdst = out + foff; const int rsub = u.pm < 64 ? 0 : MP;
#pragma unroll
        for (int ai = 0; ai < 2; ++ai)
#pragma unroll
            for (int m = 0; m < 4; ++m) {
                const int row = row0 + ai * 128 + m * 16;
                float r = rtab[(ui & 7) * 256 + (row & 255)];
                if (t == 0) r *= qs;
#pragma unroll
                for (int bj = 0; bj < 2; ++bj) {
                    const f32x4 v0 = acc[ai][bj][m][0] * r, v1 = acc[ai][bj][m][1] * r;
                    *(u32x4*)(bdst + (size_t)row * D + col0 + bj * 128) = pack8(v0, v1);
                    if (t != 0) { float* fp = fdst + (size_t)(row - rsub) * D + col0 + bj * 128; *(f32x4*)fp = v0; *(f32x4*)(fp + 4) = v1; }
                }
            }
    }
};
struct EpiRetIn {
    const LAS float* rtab; bf16_t* Qr; bf16_t* Kr; bf16_t* Vr; bf16_t* Gr;
    __device__ __forceinline__ void operator()(const Acc& acc, const pg8::Unit& u, int wr, int wc, int fr, int fq, int ui) const {
        const int pn = u.pn;
        const int row0 = u.pm * 256 + wr * 64 + fr;
        const int cc0 = wc * 32 + 8 * fq;
#pragma unroll
        for (int ai = 0; ai < 2; ++ai)
#pragma unroll
            for (int m = 0; m < 4; ++m) {
                const int row = row0 + ai * 128 + m * 16;
                const float r = rtab[(ui & 7) * 256 + (row & 255)];
                const float pos = (float)(row < MP ? (row & (SEQ - 1)) : (PAST + ((row - MP) & (DSEQ - 1))));
#pragma unroll
                for (int bj = 0; bj < 2; ++bj) {
                    f32x4 v0 = acc[ai][bj][m][0] * r, v1 = acc[ai][bj][m][1] * r;
                    const int cc = cc0 + bj * 128;
                    if (pn < 8) {
                        const float ksc = pn < 4 ? 1.0f : 0.0625f;
                        float o[8]; const float in8[8] = {v0[0], v0[1], v0[2], v0[3], v1[0], v1[1], v1[2], v1[3]};
#pragma unroll
                        for (int p = 0; p < 4; ++p) {
                            const int i = (cc >> 1) + p;
                            const float ang = fast_exp2((float)i * (-13.287712379549449f / 127.0f)) * 0.15915494309189535f;
                            const float rev = __builtin_amdgcn_fractf(pos * ang);
                            const float sn = __builtin_amdgcn_sinf(rev) * ksc, cs = __builtin_amdgcn_cosf(rev) * ksc;
                            const float x1 = in8[2 * p], x2 = in8[2 * p + 1];
                            o[2 * p] = x1 * cs - x2 * sn; o[2 * p + 1] = x2 * cs + x1 * sn;
                        }
                        u32x4 w; w.x = cvt_pk_bf16(o[0], o[1]); w.y = cvt_pk_bf16(o[2], o[3]); w.z = cvt_pk_bf16(o[4], o[5]); w.w = cvt_pk_bf16(o[6], o[7]);
                        bf16_t* dst = (pn < 4 ? Qr : Kr) + (size_t)row * D + (pn & 3) * 256 + cc;
                        *(u32x4*)dst = w;
                    } else if (pn < 16) {
                        *(u32x4*)(Vr + (size_t)row * 2048 + (pn - 8) * 256 + cc) = pack8(v0, v1);
                    } else {
#pragma unroll
                        for (int j = 0; j < 4; ++j) { v0[j] = silu_f(v0[j]); v1[j] = silu_f(v1[j]); }
                        *(u32x4*)(Gr + (size_t)row * 2048 + (pn - 16) * 256 + cc) = pack8(v0, v1);
                    }
                }
            }
    }
};

__device__ __forceinline__ unsigned gb_ld(unsigned* p) { return __hip_atomic_load(p, __ATOMIC_RELAXED, __HIP_MEMORY_SCOPE_AGENT); }
__device__ __forceinline__ unsigned gb_add(unsigned* p) { return __hip_atomic_fetch_add(p, 1u, __ATOMIC_RELAXED, __HIP_MEMORY_SCOPE_AGENT); }
__device__ __forceinline__ unsigned xcc_id() { return (unsigned)__builtin_amdgcn_s_getreg((3 << 11) | 20) & 0xFu; }
__device__ __forceinline__ void gbar(unsigned* bar, unsigned& k, unsigned G, volatile LAS unsigned* st) {
    asm volatile("s_waitcnt vmcnt(0)" ::: "memory");
    __syncthreads();
    k += 1u;
    if (threadIdx.x == 0) {
        const unsigned x = xcc_id();
        unsigned nloc = st[0], nx = st[1];
        if (nloc == 0u) {
            for (;;) {
                unsigned sum = 0u, cnt = 0u, mine = 0u;
#pragma unroll
                for (unsigned j = 0; j < 16; ++j) { const unsigned c = gb_ld(bar + 544 + j); sum += c; cnt += (c > 0u) ? 1u : 0u; mine = (j == x) ? c : mine; }
                if (sum == G) { nloc = mine; nx = cnt; break; }
                __builtin_amdgcn_s_sleep(2);
            }
            st[0] = nloc; st[1] = nx;
        }
        unsigned* sub = bar + 16 * x; unsigned* gen = bar + 256 + 16 * x; unsigned* top = bar + 512;
        const unsigned old = gb_add(sub);
        if (old + 1u == k * nloc) {
            __builtin_amdgcn_fence(__ATOMIC_RELEASE, "agent");
            asm volatile("s_waitcnt vmcnt(0)" ::: "memory");
            const unsigned ot = gb_add(top);
            if (ot + 1u != k * nx) { while (gb_ld(top) < k * nx) __builtin_amdgcn_s_sleep(1); }
            __builtin_amdgcn_fence(__ATOMIC_ACQUIRE, "agent");
            gb_add(gen);
            asm volatile("s_waitcnt vmcnt(0)" ::: "memory");
        } else {
            while (gb_ld(gen) < k) __builtin_amdgcn_s_sleep(1);
            __builtin_amdgcn_fence(__ATOMIC_ACQUIRE, "agent");
            asm volatile("s_waitcnt vmcnt(0)" ::: "memory");
        }
    }
    __syncthreads();
}

template <int K>
__device__ __forceinline__ void small_gemm_res(const bf16_t* A, const bf16_t* Bt, bf16_t* XB, u64* ssout, float alpha, LAS unsigned char* lds, int tile) {
    int tid_ = threadIdx.x; asm volatile("" : "+v"(tid_));
    const int tid = tid_, w = __builtin_amdgcn_readfirstlane(tid >> 6), lane = tid & 63, c_ = lane & 15, g = lane >> 4;
    const int row0 = MP + (tile >> 4) * 32, col0 = (tile & 15) * 64;
    constexpr int KW = K / 8, NKS = KW / 32;
    f32x4 acc[2][4];
#pragma unroll
    for (int r = 0; r < 2; ++r)
#pragma unroll
        for (int c = 0; c < 4; ++c) acc[r][c] = (f32x4){0.f, 0.f, 0.f, 0.f};
    const bf16_t* ap = A + (size_t)(row0 + c_) * K + w * KW + g * 8;
    const bf16_t* bp = Bt + (size_t)(col0 + c_) * K + w * KW + g * 8;
#pragma unroll 4
    for (int ks = 0; ks < NKS; ++ks) {
        bf16x8 a[2], b[4];
#pragma unroll
        for (int r = 0; r < 2; ++r) a[r] = *(const bf16x8*)(ap + (size_t)r * 16 * K + ks * 32);
#pragma unroll
        for (int c = 0; c < 4; ++c) b[c] = *(const bf16x8*)(bp + (size_t)c * 16 * K + ks * 32);
#pragma unroll
        for (int r = 0; r < 2; ++r)
#pragma unroll
            for (int c = 0; c < 4; ++c) acc[r][c] = mfma16(a[r], b[c], acc[r][c]);
    }
    LAS float* Pw = (LAS float*)lds;
#pragma unroll
    for (int r = 0; r < 2; ++r)
#pragma unroll
        for (int c = 0; c < 4; ++c)
#pragma unroll
            for (int j = 0; j < 4; ++j) Pw[w * 2048 + (r * 16 + 4 * g + j) * 64 + c * 16 + c_] = acc[r][c][j];
    __syncthreads();
    {
        const int m = tid >> 4, n4 = (tid & 15) * 4;
        f32x4 v = (f32x4){0.f, 0.f, 0.f, 0.f};
#pragma unroll
        for (int ww = 0; ww < 8; ++ww) v += *(const LAS f32x4*)(Pw + ww * 2048 + m * 64 + n4);
        const int row = row0 + m;
        bf16_t* xp = XB + (size_t)row * D + col0 + n4;
        const u32x2 xb = *(const u32x2*)xp;
        f32x4 x = (f32x4){bf16lo(xb.x), bf16hi(xb.x), bf16lo(xb.y), bf16hi(xb.y)}; x += alpha * v;
        u32x2 wv; wv.x = cvt_pk_bf16(x[0], x[1]); wv.y = cvt_pk_bf16(x[2], x[3]);
        *(u32x2*)xp = wv;
        float sq = x[0] * x[0] + x[1] * x[1] + x[2] * x[2] + x[3] * x[3];
        sq += __shfl_xor(sq, 1); sq += __shfl_xor(sq, 2); sq += __shfl_xor(sq, 4); sq += __shfl_xor(sq, 8);
        if ((tid & 15) == 0) atomicAdd(ssout + row, (u64)(sq * SS_FX));
    }
    __syncthreads();
}

__device__ __forceinline__ void build_rtab(LAS unsigned char* lds, const pg8::StaticOrder& S, const u64* ss) {
    int tid_ = threadIdx.x; asm volatile("" : "+v"(tid_));
    const int tid = tid_;
    LAS float* rtab = (LAS float*)(lds + LDS_RTAB);
    u64 v[4]; bool ok[4];
#pragma unroll
    for (int j = 0; j < 4; ++j) {
        const int idx = tid + 512 * j, ui = idx >> 8; pg8::Unit u;
        ok[j] = S.next(ui, u);
        v[j] = ok[j] ? ss[u.pm * 256 + (idx & 255)] : 0ull;
    }
#pragma unroll
    for (int j = 0; j < 4; ++j) if (ok[j]) rtab[tid + 512 * j] = rsqrtf((float)v[j] * (SS_INV / 1024.0f) + 1e-6f);
    __syncthreads();
}

__device__ __forceinline__ void prep_phase(const Params& P, LAS unsigned char* lds) {
    int tid_ = threadIdx.x; asm volatile("" : "+v"(tid_));
    const int tid = tid_, G = gridDim.x, bid = blockIdx.x;
    unsigned char* ws = P.ws;
    {
        unsigned* ctl = (unsigned*)(ws + WS_CTL);
        u64* ss = (u64*)(ws + WS_SS);
        const size_t nz = 6ull * MT;
        for (size_t i = (size_t)bid * NTHREADS + tid; i < nz; i += (size_t)G * NTHREADS) ss[MT + i] = 0ull;
        if (bid == 0) { ctl[tid] = 0u; ctl[tid + 512] = 0u; }
    }
    {
        bf16_t* XB = (bf16_t*)(ws + WS_XB); u64* ss0 = (u64*)(ws + WS_SS);
        const int wave = tid >> 6, lane = tid & 63;
        for (int row = bid * 8 + wave; row < MT; row += G * 8) {
            const float* src = row < MP ? P.in[0] + (size_t)row * D : P.in[1] + (size_t)(row - MP) * D;
            float sq = 0.f;
#pragma unroll
            for (int i = 0; i < 2; ++i) {
                const int c = i * 512 + lane * 8;
                const f32x4 a = *(const f32x4*)(src + c), b = *(const f32x4*)(src + c + 4);
                *(u32x4*)(XB + (size_t)row * D + c) = pack8(a, b);
                sq += a[0] * a[0] + a[1] * a[1] + a[2] * a[2] + a[3] * a[3] + b[0] * b[0] + b[1] * b[1] + b[2] * b[2] + b[3] * b[3];
            }
#pragma unroll
            for (int o = 32; o >= 1; o >>= 1) sq += __shfl_xor(sq, o);
            if (lane == 0) ss0[row] = (u64)(sq * SS_FX);
        }
    }
    {
        constexpr int NT_TOTAL = 11520;
        f32x4 ra, rb; float rg = 1.f; bf16_t* rdp = nullptr;
        auto fetch = [&](int tile) {
            const float* src; const float* gain = nullptr; bf16_t* dst; int K, N, rowadd = 0, interleave = 0, lt;
            if (tile < 5632) {
                const int job = tile / 704; lt = tile % 704; const int f = job & 3, up = job >> 2, layer = f >> 1;
                K = 1024; N = 2816; interleave = 1; rowadd = up * 128;
                src = P.in[(f & 1) ? (up ? 21 : 20) : (up ? 7 : 6)] + (size_t)layer * 1024 * 2816;
                gain = P.in[(f & 1) ? 19 : 5] + layer * 1024;
                dst = (bf16_t*)(ws + WS_WGU + f * WGU_BYTES);
            } else if (tile < 8448) {
                const int f = (tile - 5632) / 704; lt = (tile - 5632) % 704; const int layer = f >> 1;
                K = 2816; N = 1024; src = P.in[(f & 1) ? 22 : 8] + (size_t)layer * 2816 * 1024; dst = (bf16_t*)(ws + WS_WD + f * WD_BYTES);
            } else if (tile < 9216) { lt = tile - 8448; K = 1024; N = 3072; src = P.in[10]; gain = P.in[9]; dst = (bf16_t*)(ws + WS_WQKV); }
            else if (tile < 9472) { lt = tile - 9216; K = 1024; N = 1024; src = P.in[16]; dst = (bf16_t*)(ws + WS_WO); }
            else if (tile < 11008) { lt = tile - 9472; K = 1024; N = 6144; src = P.in[17]; gain = P.in[9] + 1024; dst = (bf16_t*)(ws + WS_WRIN); }
            else { lt = tile - 11008; K = 2048; N = 1024; src = P.in[18]; dst = (bf16_t*)(ws + WS_WRO); }
            const int ntn = N / 64, k0 = (lt / ntn) * 64, n0 = (lt % ntn) * 64;
            const int k = tid >> 3, n8 = (tid & 7) * 8;
            const float* sp = src + (size_t)(k0 + k) * N + n0 + n8;
            ra = *(const f32x4*)sp; rb = *(const f32x4*)(sp + 4);
            rg = gain ? gain[k0 + k] : 1.0f;
            const int ng = n0 + (tid >> 3);
            const int drow = interleave ? ((ng >> 7) * 256 + rowadd + (ng & 127)) : ng;
            rdp = dst + (size_t)drow * K + k0 + (tid & 7) * 8;
        };
        int tile = bid, it = 0;
        if (tile < NT_TOTAL) fetch(tile);
        for (; tile < NT_TOTAL; tile += G, ++it) {
            LAS bf16_t* T = (LAS bf16_t*)(lds + (it & 1) * 16384);
            {
                const int k = tid >> 3, n8 = (tid & 7) * 8;
                *(LAS u32x4*)(T + k * 72 + n8) = pack8(ra * rg, rb * rg);
            }
            bf16_t* dp = rdp;
            LDS_BARRIER();
            if (tile + G < NT_TOTAL) fetch(tile + G);
            {
                const int n = tid >> 3, k8 = (tid & 7) * 8;
                unsigned w[4];
#pragma unroll
                for (int j = 0; j < 4; ++j) { const unsigned lo = T[(k8 + 2 * j) * 72 + n], hi = T[(k8 + 2 * j + 1) * 72 + n]; w[j] = lo | (hi << 16); }
                u32x4 wv; wv.x = w[0]; wv.y = w[1]; wv.z = w[2]; wv.w = w[3];
                *(u32x4*)dp = wv;
            }
        }
        LDS_BARRIER();
    }
}

constexpr int ATT_ITEMS = 64 + 1024;
__device__ __forceinline__ void attn_item(const Params& P, LAS unsigned char* lds, int item, float lam) {
    int tid_ = threadIdx.x; asm volatile("" : "+v"(tid_));
    const int tid = tid_, w = __builtin_amdgcn_readfirstlane(tid >> 6), lane = tid & 63, c_ = lane & 15, g = lane >> 4;
    const int map = w >> 2, rg = w & 3;
    unsigned char* ws = P.ws;
    const bf16_t* Qb = (const bf16_t*)(ws + WS_SCR); const bf16_t* Kb = Qb + (size_t)MT * D; const bf16_t* Vb = Kb + (size_t)MT * D; bf16_t* Ob = (bf16_t*)(Vb + (size_t)MT * D);
    int b, h, qrow0, nkt, kvrow0; bool sample;
    if (item < 64) { sample = true; b = item >> 2; h = item & 3; qrow0 = MP + b * DSEQ; nkt = 33; kvrow0 = 0; }
    else { sample = false; const int idx = item - 64; const int qb = 63 - (idx >> 4); const int bh = idx & 15; b = bh >> 2; h = bh & 3; qrow0 = b * SEQ + qb * 64; nkt = qb + 1; kvrow0 = b * SEQ; }
    const bool active = sample ? (rg < 2) : true;
    bf16x8 qf[4];
    {
        const int qrow = qrow0 + (active ? rg * 16 : 0) + c_;
        const bf16_t* qp = Qb + (size_t)qrow * D + h * 256 + map * 128 + g * 8;
#pragma unroll
        for (int ks = 0; ks < 4; ++ks) qf[ks] = *(const bf16x8*)(qp + ks * 32);
    }
    f32x4 o[16];
#pragma unroll
    for (int i = 0; i < 16; ++i) o[i] = (f32x4){0.f, 0.f, 0.f, 0.f};
    float mrun = -1e30f, lrun = 0.f;
    u32x4 pre[8]; f32x4 raw[16];
    const float* ck = P.in[2]; const float* cv = P.in[3];
    auto load_tile = [&](int kt) {
#pragma unroll
        for (int i = 0; i < 8; ++i) {
            const int pid = tid + 512 * (i & 3), isV = i >> 2, key = pid >> 5, chunk = pid & 31;
            if (!sample) {
                const bf16_t* sp = (isV ? Vb : Kb) + (size_t)(kvrow0 + kt * 64 + key) * D + h * 256 + chunk * 8;
                pre[i] = *(const u32x4*)sp;
            } else if (kt < 32) {
                const float* sp = (isV ? cv : ck) + ((size_t)(b * PAST + kt * 64 + key)) * D + h * 256 + chunk * 8;
                raw[2 * i] = *(const f32x4*)sp; raw[2 * i + 1] = *(const f32x4*)(sp + 4);
            } else {
                if (key < 32) { const bf16_t* sp = (isV ? Vb : Kb) + (size_t)(MP + b * DSEQ + key) * D + h * 256 + chunk * 8; pre[i] = *(const u32x4*)sp; }
                else pre[i] = (u32x4){0u, 0u, 0u, 0u};
            }
        }
    };
    load_tile(0);
    const int q4 = c_ >> 2, p4 = c_ & 3, sw = (4 * g + q4) & 7;
    for (int kt = 0; kt < nkt; ++kt) {
        LDS_BARRIER();
#pragma unroll
        for (int i = 0; i < 8; ++i) {
            const int pid = tid + 512 * (i & 3), isV = i >> 2, key = pid >> 5, chunk = pid & 31;
            int off;
            if (!isV) off = (chunk >> 4) * 16384 + 256 * key + 16 * ((chunk & 15) ^ (key & 15));
            else off = 32768 + (chunk >> 4) * 16384 + 256 * key + 32 * (((chunk & 15) >> 1) ^ (key & 7)) + 16 * (chunk & 1);
            *(LAS u32x4*)(lds + off) = (sample && kt < 32) ? pack8(raw[2 * i], raw[2 * i + 1]) : pre[i];
        }
        LDS_BARRIER();
        if (kt + 1 < nkt) load_tile(kt + 1);
        if (active) {
            f32x4 s[4];
#pragma unroll
            for (int t = 0; t < 4; ++t) {
                s[t] = (f32x4){0.f, 0.f, 0.f, 0.f};
#pragma unroll
                for (int ks = 0; ks < 4; ++ks) {
                    const bf16x8 kf = *(const LAS bf16x8*)(lds + map * 16384 + 256 * (16 * t + c_) + 16 * ((4 * ks + g) ^ c_));
                    s[t] = mfma16(kf, qf[ks], s[t]);
                }
            }
            if (sample && kt == 32) { s[2] = (f32x4){-1e30f, -1e30f, -1e30f, -1e30f}; s[3] = s[2]; }
            float mx = -1e30f;
#pragma unroll
            for (int t = 0; t < 4; ++t)
#pragma unroll
                for (int j = 0; j < 4; ++j) mx = fmaxf(mx, s[t][j]);
            mx = fmaxf(mx, __shfl_xor(mx, 16)); mx = fmaxf(mx, __shfl_xor(mx, 32));
            const float mnew = fmaxf(mrun, mx), alpha = fast_exp2(mrun - mnew);
            mrun = mnew;
            float lsum = 0.f;
#pragma unroll
            for (int t = 0; t < 4; ++t)
#pragma unroll
                for (int j = 0; j < 4; ++j) { s[t][j] = fast_exp2(s[t][j] - mnew); lsum += s[t][j]; }
            lrun = lrun * alpha + lsum;
#pragma unroll
            for (int i = 0; i < 16; ++i) o[i] *= alpha;
            bf16x8 pf[2];
            pf[0] = as_bf16x8(pack8(s[0], s[1])); pf[1] = as_bf16x8(pack8(s[2], s[3]));
#pragma unroll
            for (int dvt = 0; dvt < 16; ++dvt) {
#pragma unroll
                for (int s2 = 0; s2 < 2; ++s2) {
                    const int base = 32768 + (dvt >> 3) * 16384 + 256 * (32 * s2 + 4 * g + q4) + 32 * ((dvt & 7) ^ sw) + 8 * p4;
                    const s16x4 a0 = tr_read(lds + base), a1 = tr_read(lds + base + 256 * 16);
                    o[dvt] = mfma16(cat8(a0, a1), pf[s2], o[dvt]);
                }
            }
        }
    }
    LDS_BARRIER();
    float lt = lrun + __shfl_xor(lrun, 16); lt += __shfl_xor(lt, 32);
    const float inv = 1.0f / lt;
    LAS float* X2 = (LAS float*)lds;
    if (active && map == 1) {
        const float sc = inv * lam;
#pragma unroll
        for (int dvt = 0; dvt < 16; ++dvt) *(LAS f32x4*)(X2 + (rg * 16 + c_) * 260 + 16 * dvt + 4 * g) = o[dvt] * sc;
    }
    LDS_BARRIER();
    if (active && map == 0) {
        float sq = 0.f;
#pragma unroll
        for (int dvt = 0; dvt < 16; ++dvt) {
            const f32x4 x2 = *(const LAS f32x4*)(X2 + (rg * 16 + c_) * 260 + 16 * dvt + 4 * g);
            o[dvt] = o[dvt] * inv - x2;
            sq += o[dvt][0] * o[dvt][0] + o[dvt][1] * o[dvt][1] + o[dvt][2] * o[dvt][2] + o[dvt][3] * o[dvt][3];
        }
        sq += __shfl_xor(sq, 16); sq += __shfl_xor(sq, 32);
        const float r = rsqrtf(sq * (1.0f / 256.0f) + 1e-5f) * 0.8f;
        bf16_t* op = Ob + (size_t)(qrow0 + rg * 16 + c_) * D + h * 256 + 4 * g;
#pragma unroll
        for (int dvt = 0; dvt < 16; ++dvt) {
            const f32x4 gn = *(const LAS f32x4*)(lds + LDS_RTAB + (16 * dvt + 4 * g) * 4);
            const f32x4 v = o[dvt] * r * gn;
            u32x2 wv; wv.x = cvt_pk_bf16(v[0], v[1]); wv.y = cvt_pk_bf16(v[2], v[3]);
            *(u32x2*)(op + 16 * dvt) = wv;
        }
    }
}

constexpr int ATTP_ITEMS = 512;
__device__ __forceinline__ void attn_item_p(const Params& P, LAS unsigned char* lds, int idx, float lam) {
    int tid_ = threadIdx.x; asm volatile("" : "+v"(tid_));
    const int tid = tid_, w = __builtin_amdgcn_readfirstlane(tid >> 6), lane = tid & 63, c_ = lane & 15, g = lane >> 4;
    const int map = w >> 2, rg = w & 3;
    unsigned char* ws = P.ws;
    const bf16_t* Qb = (const bf16_t*)(ws + WS_SCR); const bf16_t* Kb = Qb + (size_t)MT * D; const bf16_t* Vb = Kb + (size_t)MT * D; bf16_t* Ob = (bf16_t*)(Vb + (size_t)MT * D);
    const int qb = 31 - (idx >> 4), bh = idx & 15, b = bh >> 2, h = bh & 3;
    const int qrow0 = b * SEQ + qb * 128, nkt = 2 * qb + 2, kvrow0 = b * SEQ;
    const int nkt_w = (rg >= 2) ? nkt : nkt - 1;
    const int region = w >> 1;
    const bf16_t* dsrc = (region < 2 ? Kb : Vb) + (size_t)kvrow0 * D + h * 256 + (region & 1) * 128;
    unsigned dvoff[4];
#pragma unroll
    for (int q = 0; q < 4; ++q) {
        const int k15 = 4 * q + g, k7 = k15 & 7;
        const int col = (region < 2) ? ((c_ ^ k15) * 8) : ((2 * ((c_ >> 1) ^ k7) + (c_ & 1)) * 8);
        dvoff[q] = (unsigned)(g * D + col) * 2u;
    }
#define ATTP_DMA(kt, buf) do { _Pragma("unroll") for (int j = 0; j < 8; ++j) { \
        const int r16 = 8 * (w & 1) + j; \
        const char* gb = (const char*)dsrc + (size_t)((kt) * 64 + 4 * r16) * (D * 2); \
        __builtin_amdgcn_global_load_lds((const unsigned*)(gb + dvoff[j & 3]), (LAS unsigned*)(lds + (buf) * 65536 + region * 16384 + r16 * 1024), 16, 0, 0); } } while (0)
    ATTP_DMA(0, 0);
    bf16x8 qf[2][4];
#pragma unroll
    for (int cg2 = 0; cg2 < 2; ++cg2) {
        const bf16_t* qp = Qb + (size_t)(qrow0 + rg * 32 + cg2 * 16 + c_) * D + h * 256 + map * 128 + g * 8;
#pragma unroll
        for (int ks = 0; ks < 4; ++ks) qf[cg2][ks] = *(const bf16x8*)(qp + ks * 32);
    }
    f32x4 o[2][16];
#pragma unroll
    for (int cg2 = 0; cg2 < 2; ++cg2)
#pragma unroll
        for (int i = 0; i < 16; ++i) o[cg2][i] = (f32x4){0.f, 0.f, 0.f, 0.f};
    float mrun[2] = {-1e30f, -1e30f}, lrun[2] = {0.f, 0.f};
    const int q4 = c_ >> 2, p4 = c_ & 3, sw = (4 * g + q4) & 7;
    asm volatile("s_waitcnt vmcnt(0)" ::: "memory");
    LDS_BARRIER();
    for (int kt = 0; kt < nkt; ++kt) {
        const int bo = (kt & 1) * 65536;
        if (kt + 1 < nkt) { if (kt & 1) ATTP_DMA(kt + 1, 0); else ATTP_DMA(kt + 1, 1); }
        if (kt < nkt_w) {
#pragma unroll
            for (int s2 = 0; s2 < 2; ++s2) {
                int cl = c_; const int swl = sw; asm volatile("" : "+v"(cl));
                f32x4 s[2][2];
                {
                    const int kb0 = bo + map * 16384 + 256 * (32 * s2 + cl);
                    bf16x8 kf = *(const LAS bf16x8*)(lds + kb0 + 16 * (g ^ cl));
                    __builtin_amdgcn_s_setprio(1);
#pragma unroll
                    for (int it = 0; it < 8; ++it) {
                        const int t2 = it >> 2, ks = it & 3;
                        bf16x8 kn = kf;
                        if (it < 7) { const int t2n = (it + 1) >> 2, ksn = (it + 1) & 3; kn = *(const LAS bf16x8*)(lds + kb0 + 4096 * t2n + 16 * ((4 * ksn + g) ^ cl)); }
                        if (ks == 0) { s[0][t2] = (f32x4){0.f, 0.f, 0.f, 0.f}; s[1][t2] = s[0][t2]; }
                        s[0][t2] = mfma16(kf, qf[0][ks], s[0][t2]);
                        s[1][t2] = mfma16(kf, qf[1][ks], s[1][t2]);
                        kf = kn;
                        __builtin_amdgcn_sched_barrier(0);
                    }
                    __builtin_amdgcn_s_setprio(0);
                }
                bf16x8 pf[2];
#pragma unroll
                for (int cg2 = 0; cg2 < 2; ++cg2) {
                    float mx = -1e30f;
#pragma unroll
                    for (int t2 = 0; t2 < 2; ++t2)
#pragma unroll
                        for (int j = 0; j < 4; ++j) mx = fmaxf(mx, s[cg2][t2][j]);
                    if (__builtin_amdgcn_ballot_w64(mx > mrun[cg2] + 8.0f) != 0ull) {
                        mx = fmaxf(mx, __shfl_xor(mx, 16)); mx = fmaxf(mx, __shfl_xor(mx, 32));
                        const float mnew = fmaxf(mrun[cg2], mx), alpha = fast_exp2(mrun[cg2] - mnew);
                        mrun[cg2] = mnew;
                        lrun[cg2] *= alpha;
#pragma unroll
                        for (int i = 0; i < 16; ++i) o[cg2][i] *= alpha;
                    }
                    const float mcur = mrun[cg2];
                    float lsum = 0.f;
#pragma unroll
                    for (int t2 = 0; t2 < 2; ++t2)
#pragma unroll
                        for (int j = 0; j < 4; ++j) { s[cg2][t2][j] = fast_exp2(s[cg2][t2][j] - mcur); lsum += s[cg2][t2][j]; }
                    lrun[cg2] += lsum;
                    pf[cg2] = as_bf16x8(pack8(s[cg2][0], s[cg2][1]));
                }
                {
                    const int vb0 = bo + 32768 + 256 * (32 * s2 + 4 * g + q4) + 8 * p4;
                    s16x4 a0 = tr_read(lds + vb0 + 32 * (0 ^ swl)), a1 = tr_read(lds + vb0 + 32 * (0 ^ swl) + 256 * 16);
                    __builtin_amdgcn_s_setprio(1);
#pragma unroll
                    for (int dvt = 0; dvt < 16; ++dvt) {
                        s16x4 b0 = a0, b1 = a1;
                        if (dvt < 15) {
                            const int nb = vb0 + ((dvt + 1) >> 3) * 16384 + 32 * (((dvt + 1) & 7) ^ swl);
                            b0 = tr_read(lds + nb); b1 = tr_read(lds + nb + 256 * 16);
                        }
                        const bf16x8 vf = cat8(a0, a1);
                        o[0][dvt] = mfma16(vf, pf[0], o[0][dvt]);
                        o[1][dvt] = mfma16(vf, pf[1], o[1][dvt]);
                        a0 = b0; a1 = b1;
                        __builtin_amdgcn_sched_barrier(0);
                    }
                    __builtin_amdgcn_s_setprio(0);
                }
            }
        }
        asm volatile("s_waitcnt vmcnt(0)" ::: "memory");
        LDS_BARRIER();
    }
#undef ATTP_DMA
    float inv[2];
#pragma unroll
    for (int cg2 = 0; cg2 < 2; ++cg2) { float lt = lrun[cg2] + __shfl_xor(lrun[cg2], 16); lt += __shfl_xor(lt, 32); inv[cg2] = 1.0f / lt; }
    LAS float* X2 = (LAS float*)lds;
    float sq[2] = {0.f, 0.f};
#pragma unroll
    for (int hf = 0; hf < 2; ++hf) {
        if (map == 1) {
#pragma unroll
            for (int cg2 = 0; cg2 < 2; ++cg2)
#pragma unroll
                for (int d8 = 0; d8 < 8; ++d8) *(LAS f32x4*)(X2 + (rg * 32 + cg2 * 16 + c_) * 132 + 16 * d8 + 4 * g) = o[cg2][8 * hf + d8] * (inv[cg2] * lam);
        }
        LDS_BARRIER();
        if (map == 0) {
#pragma unroll
            for (int cg2 = 0; cg2 < 2; ++cg2)
#pragma unroll
                for (int d8 = 0; d8 < 8; ++d8) {
                    const f32x4 x2 = *(const LAS f32x4*)(X2 + (rg * 32 + cg2 * 16 + c_) * 132 + 16 * d8 + 4 * g);
                    f32x4 v = o[cg2][8 * hf + d8] * inv[cg2] - x2;
                    o[cg2][8 * hf + d8] = v;
                    sq[cg2] += v[0] * v[0] + v[1] * v[1] + v[2] * v[2] + v[3] * v[3];
                }
        }
        LDS_BARRIER();
    }
    if (map == 0) {
#pragma unroll
        for (int cg2 = 0; cg2 < 2; ++cg2) {
            float q2 = sq[cg2]; q2 += __shfl_xor(q2, 16); q2 += __shfl_xor(q2, 32);
            const float r = rsqrtf(q2 * (1.0f / 256.0f) + 1e-5f) * 0.8f;
            bf16_t* op = Ob + (size_t)(qrow0 + rg * 32 + cg2 * 16 + c_) * D + h * 256 + 4 * g;
#pragma unroll
            for (int dvt = 0; dvt < 16; ++dvt) {
                const f32x4 gn = *(const LAS f32x4*)(lds + LDS_RTAB + (16 * dvt + 4 * g) * 4);
                const f32x4 v = o[cg2][dvt] * r * gn;
                u32x2 wv; wv.x = cvt_pk_bf16(v[0], v[1]); wv.y = cvt_pk_bf16(v[2], v[3]);
                *(u32x2*)(op + 16 * dvt) = wv;
            }
        }
    }
}
__device__ __forceinline__ void attn_phase(const Params& P, LAS unsigned char* lds) {
    const int tid = threadIdx.x;
    LAS unsigned* misc = (LAS unsigned*)(lds + LDS_MISC);
    unsigned* ctr = (unsigned*)(P.ws + WS_CTL);
    if (tid < 64) {
        const float a = P.in[11][tid] * P.in[12][tid] + P.in[11][tid + 64] * P.in[12][tid + 64];
        const float b = P.in[13][tid] * P.in[14][tid] + P.in[13][tid + 64] * P.in[14][tid + 64];
        float sa = a, sb = b;
#pragma unroll
        for (int o = 32; o >= 1; o >>= 1) { sa += __shfl_xor(sa, o); sb += __shfl_xor(sb, o); }
        if (tid == 0) ((LAS float*)misc)[1] = expf(sa) - expf(sb) + 0.2f;
    }
    __syncthreads();
    if (tid < 64) *(LAS f32x4*)(lds + LDS_RTAB + tid * 16) = *(const f32x4*)(P.in[15] + tid * 4);
    __syncthreads();
    const float lam = ((LAS float*)misc)[1];
    for (;;) {
        __syncthreads();
        if (tid == 0) misc[0] = atomicAdd(ctr, 1u);
        __syncthreads();
        const int item = (int)misc[0];
        if (item >= 64 + ATTP_ITEMS) break;
        if (item < 288) attn_item_p(P, lds, item, lam);
        else if (item < 352) attn_item(P, lds, item - 288, lam);
        else attn_item_p(P, lds, item - 64, lam);
    }
}

constexpr int RET_ITEMS = 256 + 1024;
constexpr int R_QS = 0, R_KS = 32768, R_VS = 65536, R_VD = 69632, R_PM = 73728, R_ST = 81920;

constexpr int RETP_ITEMS = 1024 + 64;
__device__ __forceinline__ void retp_item(const Params& P, LAS unsigned char* lds, int item) {
    int tid_ = threadIdx.x; asm volatile("" : "+v"(tid_));
    const int tid = tid_, w = __builtin_amdgcn_readfirstlane(tid >> 6), lane = tid & 63, c_ = lane & 15, g = lane >> 4;
    unsigned char* ws = P.ws;
    const bf16_t* Qr = (const bf16_t*)(ws + WS_SCR); const bf16_t* Kr = Qr + (size_t)MT * D;
    int h, row0, L;
    if (item < 1024) { const int bh = item >> 6, ci = item & 63; h = bh & 3; row0 = (bh >> 2) * SEQ + ci * 64; L = 64; }
    else { const int bh = item - 1024; h = bh & 3; row0 = MP + (bh >> 2) * DSEQ; L = 32; }
    const float lg2 = __log2f(1.0f - fast_exp2((float)(-5 - h)));
    u32x4 pq[4], pk[4];
#pragma unroll
    for (int i = 0; i < 4; ++i) {
        const int pid = tid + 512 * i, tok = pid >> 5, chunk = pid & 31;
        if (tok < L) { const size_t off = (size_t)(row0 + tok) * D + h * 256 + chunk * 8; pq[i] = *(const u32x4*)(Qr + off); pk[i] = *(const u32x4*)(Kr + off); }
        else { pq[i] = (u32x4){0u, 0u, 0u, 0u}; pk[i] = pq[i]; }
    }
    LDS_BARRIER();
#pragma unroll
    for (int i = 0; i < 4; ++i) {
        const int pid = tid + 512 * i, tok = pid >> 5, chunk = pid & 31;
        const int off = tok * 512 + 16 * (chunk ^ (tok & 15));
        *(LAS u32x4*)(lds + R_QS + off) = pq[i]; *(LAS u32x4*)(lds + R_KS + off) = pk[i];
    }
    LDS_BARRIER();
    {
        const int it = w >> 1, jt0 = 2 * (w & 1);
        f32x4 pa[2] = {(f32x4){0.f, 0.f, 0.f, 0.f}, (f32x4){0.f, 0.f, 0.f, 0.f}};
#pragma unroll
        for (int ks = 0; ks < 8; ++ks) {
            const bf16x8 qa = *(const LAS bf16x8*)(lds + R_QS + (16 * it + c_) * 512 + 16 * ((4 * ks + g) ^ c_));
#pragma unroll
            for (int u = 0; u < 2; ++u) {
                const bf16x8 kb = *(const LAS bf16x8*)(lds + R_KS + (16 * (jt0 + u) + c_) * 512 + 16 * ((4 * ks + g) ^ c_));
                pa[u] = mfma16(qa, kb, pa[u]);
            }
        }
#pragma unroll
        for (int u = 0; u < 2; ++u)
#pragma unroll
            for (int j = 0; j < 4; ++j) {
                const int i = 16 * it + 4 * g + j, jj = 16 * (jt0 + u) + c_;
                const float dm = (i >= jj) ? fast_exp2((float)(i - jj) * lg2) : 0.f;
                const unsigned pkd = cvt_pk_bf16(pa[u][j] * dm, 0.f);
                *(LAS bf16_t*)(lds + R_PM + i * 128 + 16 * ((jj >> 3) ^ (i & 7)) + (jj & 7) * 2) = (bf16_t)(pkd & 0xffffu);
            }
    }
    LDS_BARRIER();
    *(u32x4*)(ws + WS_PG + (size_t)item * 8192 + tid * 16) = *(const LAS u32x4*)(lds + R_PM + tid * 16);
}
__device__ __forceinline__ void ret_item(const Params& P, LAS unsigned char* lds, int item) {
    int tid_ = threadIdx.x; asm volatile("" : "+v"(tid_));
    const int tid = tid_, w = __builtin_amdgcn_readfirstlane(tid >> 6), lane = tid & 63, c_ = lane & 15, g = lane >> 4;
    const int q4 = c_ >> 2, p4 = c_ & 3;
    unsigned char* ws = P.ws;
    const bf16_t* Qr = (const bf16_t*)(ws + WS_SCR); const bf16_t* Kr = Qr + (size_t)MT * D; bf16_t* Vr = (bf16_t*)(Kr + (size_t)MT * D);
    float* rssp = (float*)(ws + WS_RSSP);
    int b, h, sl, row0, nch, L, pitem0; const float* sinit = nullptr; float* sout;
    if (item < 256) { const int bh = item >> 4; b = bh >> 2; h = bh & 3; sl = item & 15; row0 = b * SEQ; nch = 64; L = 64; pitem0 = bh * 64;
        sout = P.out + 50855936 + ((size_t)(b * 4 + h) * 256) * 512 + sl * 32; }
    else { const int it2 = item - 256; const int bh = it2 >> 4; b = bh >> 2; h = bh & 3; sl = it2 & 15; row0 = MP + b * DSEQ; nch = 1; L = 32; pitem0 = 1024 + bh;
        sinit = P.in[4] + ((size_t)(b * 4 + h) * 256) * 512 + sl * 32; sout = P.out + 54001664 + ((size_t)(b * 4 + h) * 256) * 512 + sl * 32; }
    const float lg2 = __log2f(1.0f - fast_exp2((float)(-5 - h)));
    f32x4 S[2][2];
#pragma unroll
    for (int dt = 0; dt < 2; ++dt)
#pragma unroll
        for (int et = 0; et < 2; ++et) {
#pragma unroll
            for (int j = 0; j < 4; ++j) S[dt][et][j] = sinit ? sinit[(size_t)(32 * w + 16 * dt + 4 * g + j) * 512 + 16 * et + c_] : 0.f;
        }
    auto write_st = [&]() {
#pragma unroll
        for (int dt = 0; dt < 2; ++dt)
#pragma unroll
            for (int et = 0; et < 2; ++et) {
                const int e = 16 * et + c_;
                u32x2 wv; wv.x = cvt_pk_bf16(S[dt][et][0], S[dt][et][1]); wv.y = cvt_pk_bf16(S[dt][et][2], S[dt][et][3]);
                *(LAS u32x2*)(lds + R_ST + e * 512 + 16 * ((4 * w + 2 * dt + (g >> 1)) ^ (e & 15)) + 8 * (g & 1)) = wv;
            }
    };
    u32x4 pqA[4], pkA[4], pvA, ppA, pqB[4], pkB[4], pvB, ppB;
    auto load_chunk = [&](int ci, u32x4 (&pq)[4], u32x4 (&pk)[4], u32x4& pv, u32x4& pp) {
        pp = *(const u32x4*)(ws + WS_PG + (size_t)(pitem0 + ci) * 8192 + tid * 16);
#pragma unroll
        for (int i = 0; i < 4; ++i) {
            const int pid = tid + 512 * i, tok = pid >> 5, chunk = pid & 31;
            if (tok < L) { const size_t off = (size_t)(row0 + ci * 64 + tok) * D + h * 256 + chunk * 8; pq[i] = *(const u32x4*)(Qr + off); pk[i] = *(const u32x4*)(Kr + off); }
            else { pq[i] = (u32x4){0u, 0u, 0u, 0u}; pk[i] = pq[i]; }
        }
        if (tid < 256) { const int tok = tid >> 2, chunk = tid & 3;
            if (tok < L) pv = *(const u32x4*)(Vr + (size_t)(row0 + ci * 64 + tok) * 2048 + h * 512 + sl * 32 + chunk * 8); else pv = (u32x4){0u, 0u, 0u, 0u}; }
    };
    auto stage_chunk = [&](const u32x4 (&pq)[4], const u32x4 (&pk)[4], const u32x4& pv, const u32x4& pp) {
#pragma unroll
        for (int i = 0; i < 4; ++i) {
            const int pid = tid + 512 * i, tok = pid >> 5, chunk = pid & 31;
            const int off = tok * 512 + 16 * (chunk ^ (tok & 15));
            *(LAS u32x4*)(lds + R_QS + off) = pq[i]; *(LAS u32x4*)(lds + R_KS + off) = pk[i];
        }
        *(LAS u32x4*)(lds + R_PM + tid * 16) = pp;
        if (tid < 256) { const int tok = tid >> 2, chunk = tid & 3;
            *(LAS u32x4*)(lds + R_VS + tok * 64 + chunk * 16) = pv;
            const float dk = fast_exp2((float)(L - 1 - tok) * lg2);
            u32x4 d; d.x = cvt_pk_bf16(bf16lo(pv.x) * dk, bf16hi(pv.x) * dk); d.y = cvt_pk_bf16(bf16lo(pv.y) * dk, bf16hi(pv.y) * dk);
            d.z = cvt_pk_bf16(bf16lo(pv.z) * dk, bf16hi(pv.z) * dk); d.w = cvt_pk_bf16(bf16lo(pv.w) * dk, bf16hi(pv.w) * dk);
            *(LAS u32x4*)(lds + R_VD + tok * 64 + chunk * 16) = d; }
    };
    const float sdec = fast_exp2((float)L * lg2);
    auto compute_chunk = [&](int ci) {
        {
#pragma unroll
            for (int dt = 0; dt < 2; ++dt)
#pragma unroll
                for (int et = 0; et < 2; ++et) S[dt][et] *= sdec;
#pragma unroll
            for (int ks2 = 0; ks2 < 2; ++ks2) {
                bf16x8 vb[2];
#pragma unroll
                for (int et = 0; et < 2; ++et) {
                    const int j0 = 32 * ks2 + 4 * g + q4;
                    const s16x4 a0 = tr_read(lds + R_VD + j0 * 64 + (16 * et + 4 * p4) * 2), a1 = tr_read(lds + R_VD + (j0 + 16) * 64 + (16 * et + 4 * p4) * 2);
                    vb[et] = cat8(a0, a1);
                }
#pragma unroll
                for (int dt = 0; dt < 2; ++dt) {
                    const int j0 = 32 * ks2 + 4 * g + q4, j1 = j0 + 16;
                    const int chunk = 4 * w + 2 * dt + (p4 >> 1);
                    const s16x4 a0 = tr_read(lds + R_KS + j0 * 512 + 16 * (chunk ^ (j0 & 15)) + 8 * (p4 & 1));
                    const s16x4 a1 = tr_read(lds + R_KS + j1 * 512 + 16 * (chunk ^ (j1 & 15)) + 8 * (p4 & 1));
                    const bf16x8 ka = cat8(a0, a1);
#pragma unroll
                    for (int et = 0; et < 2; ++et) S[dt][et] = mfma16(ka, vb[et], S[dt][et]);
                }
            }
        }
        {
            const int it = w >> 1, et = w & 1;
            f32x4 in = (f32x4){0.f, 0.f, 0.f, 0.f}, cr = in;
#pragma unroll
            for (int ks2 = 0; ks2 < 2; ++ks2) {
                const int i = 16 * it + c_;
                const bf16x8 pa = *(const LAS bf16x8*)(lds + R_PM + i * 128 + 16 * ((4 * ks2 + g) ^ (i & 7)));
                const int j0 = 32 * ks2 + 8 * g + q4;
                const s16x4 a0 = tr_read(lds + R_VS + j0 * 64 + (16 * et + 4 * p4) * 2), a1 = tr_read(lds + R_VS + (j0 + 4) * 64 + (16 * et + 4 * p4) * 2);
                in = mfma16(pa, cat8(a0, a1), in);
            }
#pragma unroll
            for (int ks = 0; ks < 8; ++ks) {
                const bf16x8 qa = *(const LAS bf16x8*)(lds + R_QS + (16 * it + c_) * 512 + 16 * ((4 * ks + g) ^ c_));
                const int e = 16 * et + c_;
                const bf16x8 sb = *(const LAS bf16x8*)(lds + R_ST + e * 512 + 16 * ((4 * ks + g) ^ (e & 15)));
                cr = mfma16(qa, sb, cr);
            }
#pragma unroll
            for (int j = 0; j < 4; ++j) {
                const int i = 16 * it + 4 * g + j;
                const float ov = in[j] + fast_exp2((float)(i + 1) * lg2) * cr[j];
                float sq = ov * ov;
                sq += __shfl_xor(sq, 1); sq += __shfl_xor(sq, 2); sq += __shfl_xor(sq, 4); sq += __shfl_xor(sq, 8);
                if (i < L) {
                    const int row = row0 + ci * 64 + i;
                    const unsigned pkd = cvt_pk_bf16(ov, 0.f);
                    Vr[(size_t)row * 2048 + h * 512 + sl * 32 + 16 * et + c_] = (bf16_t)(pkd & 0xffffu);
                    if (c_ == 0) rssp[((size_t)row * 4 + h) * 32 + sl * 2 + et] = sq;
                }
            }
        }
    };
    LDS_BARRIER();
    write_st();
    load_chunk(0, pqA, pkA, pvA, ppA);
    if (nch > 1) load_chunk(1, pqB, pkB, pvB, ppB);
    for (int ci = 0; ci < nch; ci += 2) {
        stage_chunk(pqA, pkA, pvA, ppA);
        LDS_BARRIER();
        if (ci + 2 < nch) load_chunk(ci + 2, pqA, pkA, pvA, ppA);
        compute_chunk(ci);
        LDS_BARRIER();
        write_st();
        if (ci + 1 < nch) {
            stage_chunk(pqB, pkB, pvB, ppB);
            LDS_BARRIER();
            if (ci + 3 < nch) load_chunk(ci + 3, pqB, pkB, pvB, ppB);
            compute_chunk(ci + 1);
            LDS_BARRIER();
            write_st();
        }
    }
#pragma unroll
    for (int dt = 0; dt < 2; ++dt)
#pragma unroll
        for (int et = 0; et < 2; ++et)
#pragma unroll
            for (int j = 0; j < 4; ++j) sout[(size_t)(32 * w + 16 * dt + 4 * g + j) * 512 + 16 * et + c_] = S[dt][et][j];
}

__global__ void __launch_bounds__(NTHREADS, 2) fwd_megakernel(Params P) {
    extern __shared__ __attribute__((aligned(16))) unsigned char lds_raw[];
    LAS unsigned char* lds = (LAS unsigned char*)lds_raw;
    cg::grid_group grid = cg::this_grid();
    unsigned char* ws = P.ws;
    const int G = gridDim.x, bid = blockIdx.x, tid = threadIdx.x;
    bf16_t* XB = (bf16_t*)(ws + WS_XB);
    u64* ss = (u64*)(ws + WS_SS);
    bf16_t* SCR = (bf16_t*)(ws + WS_SCR);
    bf16_t* H = SCR;

    unsigned* barctr = (unsigned*)(ws + WS_CTL) + 256; unsigned bartgt = 0;
#define GSYNC() gbar(barctr, bartgt, (unsigned)G, (volatile LAS unsigned*)(lds + LDS_MISC + 16))
    if (tid == 0) { ((volatile LAS unsigned*)(lds + LDS_MISC + 16))[0] = 0u; ((volatile LAS unsigned*)(lds + LDS_MISC + 16))[1] = 0u; }
    prep_phase(P, lds);
    grid.sync();
    if (tid == 0) gb_add(barctr + 544 + xcc_id());

#define ffn(f, ss_in, ss_out) do { \
        { pg8::Gemm g{XB, (const bf16_t*)(ws + WS_WGU + (f) * WGU_BYTES), MT, 5632, D}; pg8::StaticOrder S; S.init(MT, 5632, G, bid); \
          build_rtab(lds, S, ss + (size_t)(ss_in) * MT); \
          EpiGU E{(const LAS float*)(lds + LDS_RTAB), H}; pg8::gemm_phase<EpiGU>(lds, g, S, E); } \
        GSYNC(); \
        { pg8::Gemm g{H, (const bf16_t*)(ws + WS_WD + (f) * WD_BYTES), MP, D, DFF}; pg8::StaticOrder S; S.init(MP, D, G, bid); \
          EpiRes E{XB, ss + (size_t)(ss_out) * MT, 0.5f}; pg8::gemm_phase<EpiRes>(lds, g, S, E); \
          for (int tile = bid; tile < 256; tile += G) small_gemm_res<DFF>(H, (const bf16_t*)(ws + WS_WD + (f) * WD_BYTES), XB, ss + (size_t)(ss_out) * MT, 0.5f, lds, tile); } \
        GSYNC(); } while (0)

    ffn(0, 0, 1);
    {
        pg8::Gemm g{XB, (const bf16_t*)(ws + WS_WQKV), MT, 3072, D}; pg8::StaticOrder S; S.init(MT, 3072, G, bid);
        build_rtab(lds, S, ss + 1ull * MT);
        EpiQKV E{(const LAS float*)(lds + LDS_RTAB), SCR, P.out};
        pg8::gemm_phase<EpiQKV>(lds, g, S, E);
    }
    GSYNC();
    attn_phase(P, lds);
    GSYNC();
    {
        pg8::Gemm g{SCR + 3ull * MT * D, (const bf16_t*)(ws + WS_WO), MP, D, D}; pg8::StaticOrder S; S.init(MP, D, G, bid);
        EpiRes E{XB, ss + 2ull * MT, 1.0f};
        pg8::gemm_phase<EpiRes>(lds, g, S, E);
        for (int tile = bid; tile < 256; tile += G) small_gemm_res<D>(SCR + 3ull * MT * D, (const bf16_t*)(ws + WS_WO), XB, ss + 2ull * MT, 1.0f, lds, tile);
    }
    GSYNC();
    ffn(1, 2, 3);
    ffn(2, 3, 4);
    {
        pg8::Gemm g{XB, (const bf16_t*)(ws + WS_WRIN), MT, 6144, D}; pg8::StaticOrder S; S.init(MT, 6144, G, bid);
        build_rtab(lds, S, ss + 4ull * MT);
        EpiRetIn E{(const LAS float*)(lds + LDS_RTAB), SCR, SCR + (size_t)MT * D, SCR + 2ull * MT * D, SCR + 4ull * MT * D};
        pg8::gemm_phase<EpiRetIn>(lds, g, S, E);
    }
    GSYNC();
    for (int it0 = bid; it0 < RETP_ITEMS; it0 += G) retp_item(P, lds, it0);
    GSYNC();
    for (int it0 = bid; it0 < RET_ITEMS; it0 += G) {
        int item = it0;
        if (G == 256 && it0 < 256) { const int xcd = it0 & 7, j = it0 >> 3; item = (xcd * 2 + (j >> 4)) * 16 + (j & 15); }
        ret_item(P, lds, item);
    }
    GSYNC();
    {
        bf16_t* Vr = SCR + 2ull * MT * D; const bf16_t* Gr = SCR + 4ull * MT * D; const float* rssp = (const float*)(ws + WS_RSSP);
        const size_t npieces = (size_t)MT * 256;
        for (size_t p = (size_t)bid * NTHREADS + tid; p < npieces; p += (size_t)G * NTHREADS) {
            const size_t row = p >> 8; const int c8 = (int)(p & 255) * 8, hh = c8 >> 9;
            float tot = 0.f;
            {
                const f32x4* pp4 = (const f32x4*)(rssp + (row * 4 + hh) * 32);
#pragma unroll
                for (int q = 0; q < 8; ++q) { const f32x4 t4 = pp4[q]; tot += (t4[0] + t4[1]) + (t4[2] + t4[3]); }
            }
            const float r = rsqrtf(tot * (1.0f / 512.0f) + 1e-6f);
            const u32x4 ov = *(const u32x4*)(Vr + row * 2048 + c8), gv = *(const u32x4*)(Gr + row * 2048 + c8);
            u32x4 y;
            y.x = cvt_pk_bf16(bf16lo(ov.x) * bf16lo(gv.x) * r, bf16hi(ov.x) * bf16hi(gv.x) * r);
            y.y = cvt_pk_bf16(bf16lo(ov.y) * bf16lo(gv.y) * r, bf16hi(ov.y) * bf16hi(gv.y) * r);
            y.z = cvt_pk_bf16(bf16lo(ov.z) * bf16lo(gv.z) * r, bf16hi(ov.z) * bf16hi(gv.z) * r);
            y.w = cvt_pk_bf16(bf16lo(ov.w) * bf16lo(gv.w) * r, bf16hi(ov.w) * bf16hi(gv.w) * r);
            *(u32x4*)(Vr + row * 2048 + c8) = y;
        }
    }
    GSYNC();
    {
        pg8::Gemm g{SCR + 2ull * MT * D, (const bf16_t*)(ws + WS_WRO), MP, D, 2048}; pg8::StaticOrder S; S.init(MP, D, G, bid);
        EpiRes E{XB, ss + 5ull * MT, 1.0f};
        pg8::gemm_phase<EpiRes>(lds, g, S, E);
        for (int tile = bid; tile < 256; tile += G) small_gemm_res<2048>(SCR + 2ull * MT * D, (const bf16_t*)(ws + WS_WRO), XB, ss + 5ull * MT, 1.0f, lds, tile);
    }
    GSYNC();
    ffn(3, 5, 6);
    {
        const float* fg = P.in[23]; const u64* ssf = ss + 6ull * MT;
        const size_t npieces = (size_t)MT * 256;
        for (size_t p = (size_t)bid * NTHREADS + tid; p < npieces; p += (size_t)G * NTHREADS) {
            const size_t row = p >> 8; const int c4 = (int)(p & 255) * 4;
            const float r = rsqrtf((float)ssf[row] * (SS_INV / 1024.0f) + 1e-6f);
            const u32x2 xb = *(const u32x2*)(XB + row * D + c4);
            const f32x4 x = (f32x4){bf16lo(xb.x), bf16hi(xb.x), bf16lo(xb.y), bf16hi(xb.y)}, gn = *(const f32x4*)(fg + c4);
            float* dst = row < MP ? P.out + row * D + c4 : P.out + 16777216 + (row - MP) * D + c4;
            *(f32x4*)dst = x * r * gn;
        }
    }
}

extern "C" void kernel_launch(void* const* d_in, const int* in_sizes, int n_in, void* d_out, int out_size, void* d_ws, size_t ws_size, hipStream_t stream) {
    static int grid_blocks = 0;
    if (!grid_blocks) {
        if (n_in != 24 || ws_size < WS_END) { fprintf(stderr, "kernel_launch: unexpected n_in %d or ws_size %zu (< %zu)\n", n_in, ws_size, (size_t)WS_END); grid_blocks = -1; return; }
        int dev = 0, cus = 0, per_cu = 0;
        hipGetDevice(&dev);
        hipDeviceGetAttribute(&cus, hipDeviceAttributeMultiprocessorCount, dev);
        hipFuncSetAttribute((const void*)fwd_megakernel, hipFuncAttributeMaxDynamicSharedMemorySize, LDS_BYTES);
        hipOccupancyMaxActiveBlocksPerMultiprocessor(&per_cu, (const void*)fwd_megakernel, NTHREADS, LDS_BYTES);
        if (per_cu < 1) per_cu = 1;
        grid_blocks = cus * per_cu;
    }
    if (grid_blocks < 0) return;
    Params p{};
    for (int i = 0; i < 24; ++i) p.in[i] = (const float*)d_in[i];
    p.out = (float*)d_out; p.ws = (unsigned char*)d_ws;
    void* args[] = {&p};
    hipError_t e = hipLaunchCooperativeKernel((const void*)fwd_megakernel, dim3(grid_blocks), dim3(NTHREADS), args, LDS_BYTES, stream);
    if (e != hipSuccess) fprintf(stderr, "cooperative launch failed: %s (grid %d)\n", hipGetErrorString(e), grid_blocks);
}
```

```cpp
#include <hip/hip_runtime.h>
#include <hip/hip_cooperative_groups.h>
#include <cstdio>
namespace cg = cooperative_groups;

#define LAS __attribute__((address_space(3)))
typedef unsigned short bf16_t;
typedef short bf16x8 __attribute__((ext_vector_type(8)));
typedef short s16x4 __attribute__((ext_vector_type(4)));
typedef float f32x4 __attribute__((ext_vector_type(4)));
typedef unsigned u32x4 __attribute__((ext_vector_type(4)));
typedef unsigned u32x2 __attribute__((ext_vector_type(2)));
typedef unsigned long long u64;
#define SS_FX 1048576.0f
#define SS_INV (1.0f / 1048576.0f)

constexpr int D = 1024, DFF = 2816, MP = 16384, MS = 512, MT = MP + MS;
constexpr int SEQ = 4096, PAST = 2048, DSEQ = 32;
constexpr int NTHREADS = 512;
constexpr int LDS_BYTES = 131072 + 256 + 8192;
constexpr int LDS_MISC = 131072;
constexpr int LDS_RTAB = 131072 + 256;

constexpr size_t WS_CTL = 0;
constexpr size_t WS_SS = 4096;
constexpr size_t WS_RSS = WS_SS + 7ull * MT * 4;
constexpr size_t WS_WGU = 1ull << 20;
constexpr size_t WGU_BYTES = 5632ull * 1024 * 2;
constexpr size_t WS_WD = WS_WGU + 4 * WGU_BYTES;
constexpr size_t WD_BYTES = 1024ull * 2816 * 2;
constexpr size_t WS_WQKV = WS_WD + 4 * WD_BYTES;
constexpr size_t WS_WO = WS_WQKV + 3072ull * 1024 * 2;
constexpr size_t WS_WRIN = WS_WO + 1024ull * 1024 * 2;
constexpr size_t WS_WRO = WS_WRIN + 6144ull * 1024 * 2;
constexpr size_t WS_X = WS_WRO + 1024ull * 2048 * 2;
constexpr size_t WS_XB = WS_X + (size_t)MT * D * 4;
constexpr size_t WS_SCR = WS_XB + (size_t)MT * D * 2;
constexpr size_t ACT1 = (size_t)MT * D * 2;
constexpr size_t WS_END = WS_SCR + 6 * ACT1;
constexpr size_t WS_PG = WS_WGU + WGU_BYTES;
constexpr size_t WS_RSSP = WS_WGU;
static_assert(1088ull * 8192 <= WGU_BYTES && (size_t)MT * 4 * 32 * 4 <= WGU_BYTES, "aliased regions");

struct Params {
    const float* in[24];
    float* out;
    unsigned char* ws;
};

#define LDS_BARRIER() do { asm volatile("s_waitcnt lgkmcnt(0)" ::: "memory"); __builtin_amdgcn_s_barrier(); asm volatile("" ::: "memory"); } while (0)
__device__ __forceinline__ unsigned cvt_pk_bf16(float lo, float hi) { unsigned r; asm("v_cvt_pk_bf16_f32 %0, %1, %2" : "=v"(r) : "v"(lo), "v"(hi)); return r; }
__device__ __forceinline__ float bf16lo(unsigned u) { return __uint_as_float(u << 16); }
__device__ __forceinline__ float bf16hi(unsigned u) { return __uint_as_float(u & 0xffff0000u); }
__device__ __forceinline__ float fast_exp2(float x) { return __builtin_amdgcn_exp2f(x); }
__device__ __forceinline__ float fast_rcp(float x) { return __builtin_amdgcn_rcpf(x); }
__device__ __forceinline__ float silu_f(float x) { return x * fast_rcp(1.0f + fast_exp2(-1.44269504089f * x)); }
__device__ __forceinline__ u32x4 pack8(f32x4 a, f32x4 b) { u32x4 w; w.x = cvt_pk_bf16(a[0], a[1]); w.y = cvt_pk_bf16(a[2], a[3]); w.z = cvt_pk_bf16(b[0], b[1]); w.w = cvt_pk_bf16(b[2], b[3]); return w; }
__device__ __forceinline__ f32x4 mfma16(bf16x8 a, bf16x8 b, f32x4 c) { return __builtin_amdgcn_mfma_f32_16x16x32_bf16(a, b, c, 0, 0, 0); }
__device__ __forceinline__ s16x4 tr_read(LAS unsigned char* p) { return __builtin_amdgcn_ds_read_tr16_b64_v4i16((LAS s16x4*)p); }
__device__ __forceinline__ bf16x8 cat8(s16x4 a, s16x4 b) { bf16x8 r = {a[0], a[1], a[2], a[3], b[0], b[1], b[2], b[3]}; return r; }
__device__ __forceinline__ bf16x8 as_bf16x8(u32x4 v) { union { u32x4 u; bf16x8 s; } x; x.u = v; return x.s; }

namespace pg8 {
constexpr int BM = 256, BK = 64, HALF = 128, HTB = HALF * BK * 2, STAGE_BYTES = 8 * HTB, NXCD = 8, WGM = 8;
__host__ __device__ __forceinline__ int lds_byte(int r, int c) { const int st = (r >> 4) * 2 + (c >> 5), rr = r & 15, cc = c & 31, ob = rr * 64 + cc * 2; return st * 1024 + (ob ^ (((ob >> 9) & 1) << 5)); }
__host__ __device__ __forceinline__ void stage_rc(int b, int& R, int& C) { const int st = b / 1024, sb = b % 1024, swz = sb ^ (((sb >> 9) & 1) << 5); R = (st >> 1) * 16 + swz / 64; C = (st & 1) * 32 + (swz % 64) / 2; }
__host__ __device__ __forceinline__ int perm32(int rho) { const int n = rho >> 4, i = rho & 15; return 8 * (i >> 2) + 4 * n + (i & 3); }
struct Unit { int pm, pn; };
struct Gemm { const bf16_t* A; const bf16_t* Bt; int M, N, K; };
struct StaticOrder {
    int nM, nN, nwg, G, c;
    __device__ void init(int M, int N, int G_, int c_) { nM = M / BM; nN = N / BM; nwg = nM * nN; G = G_; c = c_; }
    __device__ bool next(int i, Unit& u) const {
        const long L = (long)i * G + c; if (L >= nwg) return false;
        int wgid = (int)L; { const int q = nwg / NXCD, r = nwg % NXCD, xcd = wgid % NXCD, off = wgid / NXCD; wgid = (xcd < r ? xcd * (q + 1) : r * (q + 1) + (xcd - r) * q) + off; }
        const int nig = WGM * nN, gid = wgid / nig, fm = gid * WGM, gsz = (nM - fm) < WGM ? (nM - fm) : WGM;
        u.pm = fm + ((wgid % nig) % gsz); u.pn = (wgid % nig) / gsz; return true;
    }
};
template <class Epi>
__device__ __forceinline__ void gemm_phase(LAS unsigned char* lds, const Gemm g, const StaticOrder& S, const Epi& E) {
    int tid_ = threadIdx.x; asm volatile("" : "+v"(tid_));
    const int tid = tid_, wid = __builtin_amdgcn_readfirstlane(tid >> 6), lane = tid & 63, wr = wid >> 2, wc = wid & 3, fr = lane & 15, fq = lane >> 4;
    const int K = g.K, nt = K / BK;
    unsigned voffA[2], voffB[2];
#pragma unroll
    for (int i = 0; i < 2; ++i) { int R, C; stage_rc(tid * 16 + i * 8192, R, C); const int Rb = (R & ~31) + perm32(R & 31);
        voffA[i] = (unsigned)(R * K + C) * 2u; voffB[i] = (unsigned)(Rb * K + C) * 2u; }
    const size_t kstep = (size_t)(BK * 2);
    const size_t hstep = (size_t)HALF * K * 2;
    const size_t tstep = 2 * hstep;
    const unsigned ldsw = (unsigned)wid * 1024u;
    const int aoff = lds_byte(wr * 64 + fr, fq * 8), boff = lds_byte(wc * 32 + fr, fq * 8);
#define PG8_SA(b, h) (((b) * 2 + (h)) * HTB)
#define PG8_SB(b, h) ((4 + (b) * 2 + (h)) * HTB)
#define PG8_STAGE(bufoff, gbase, voff) do { _Pragma("unroll") for (int _i = 0; _i < 2; ++_i) \
        __builtin_amdgcn_global_load_lds((const unsigned*)((const char*)(gbase) + (voff)[_i]), (LAS unsigned*)(lds + (bufoff) + ldsw + _i * 8192), 16, 0, 0); } while (0)
#define PG8_LDA(dst, b, h) do { _Pragma("unroll") for (int m = 0; m < 4; ++m) _Pragma("unroll") for (int k = 0; k < 2; ++k) dst[m][k] = *(const LAS bf16x8*)(lds + PG8_SA(b, h) + aoff + m * 2048 + k * 1024); } while (0)
#define PG8_LDB(dst, b, h) do { _Pragma("unroll") for (int n = 0; n < 2; ++n) _Pragma("unroll") for (int k = 0; k < 2; ++k) dst[n][k] = *(const LAS bf16x8*)(lds + PG8_SB(b, h) + boff + n * 2048 + k * 1024); } while (0)
#define PG8_MMA(ai, bj, At, Bt) do { __builtin_amdgcn_s_setprio(1); _Pragma("unroll") for (int m = 0; m < 4; ++m) _Pragma("unroll") for (int n = 0; n < 2; ++n) _Pragma("unroll") for (int k = 0; k < 2; ++k) \
        acc[ai][bj][m][n] = __builtin_amdgcn_mfma_f32_16x16x32_bf16(Bt[n][k], At[m][k], acc[ai][bj][m][n], 0, 0, 0); __builtin_amdgcn_s_setprio(0); } while (0)
#define PG8_WAIT_V(n) asm volatile("s_waitcnt vmcnt(" #n ")" ::: "memory")
#define PG8_WAIT_L(n) asm volatile("s_waitcnt lgkmcnt(" #n ")" ::: "memory")
#define PG8_BAR __builtin_amdgcn_s_barrier()
#define PG8_SCHED __builtin_amdgcn_sched_barrier(0)
    Unit cur, nxt; int ui = 0;
    if (!S.next(0, cur)) return;
    f32x4 acc[2][2][4][2];
#pragma unroll
    for (int a = 0; a < 2; ++a)
#pragma unroll
        for (int b = 0; b < 2; ++b)
#pragma unroll
            for (int m = 0; m < 4; ++m)
#pragma unroll
                for (int n = 0; n < 2; ++n) acc[a][b][m][n] = (f32x4){0.f, 0.f, 0.f, 0.f};
    bf16x8 At[4][2], B0[2][2], B1[2][2];
    const char* cA = (const char*)g.A + (size_t)cur.pm * tstep; const char* cB = (const char*)g.Bt + (size_t)cur.pn * tstep;
    PG8_STAGE(PG8_SB(0, 0), cB, voffB); PG8_STAGE(PG8_SA(0, 0), cA, voffA); PG8_STAGE(PG8_SB(0, 1), cB + hstep, voffB); PG8_STAGE(PG8_SA(0, 1), cA + hstep, voffA);
    if (wr == 1) PG8_BAR;
    PG8_WAIT_V(4); PG8_BAR;
    PG8_STAGE(PG8_SB(1, 0), cB + kstep, voffB); PG8_STAGE(PG8_SA(1, 0), cA + kstep, voffA); PG8_STAGE(PG8_SB(1, 1), cB + hstep + kstep, voffB);
    PG8_WAIT_V(6); PG8_BAR;
    for (;;) {
        const bool has_next = S.next(ui + 1, nxt);
        const char* nA = has_next ? (const char*)g.A + (size_t)nxt.pm * tstep : cA; const char* nB = has_next ? (const char*)g.Bt + (size_t)nxt.pn * tstep : cB;
        for (int t = 0; t < nt; t += 2) {
            const bool last = (t == nt - 2);
            const char* a1 = cA + (size_t)(t + 1) * kstep;
            const char* a2 = last ? nA : cA + (size_t)(t + 2) * kstep; const char* b2 = last ? nB : cB + (size_t)(t + 2) * kstep;
            const char* a3 = a2 + kstep; const char* b3 = b2 + kstep;
            PG8_LDB(B0, 0, 0); PG8_SCHED; PG8_LDA(At, 0, 0); PG8_STAGE(PG8_SA(1, 1), a1 + hstep, voffA);
            PG8_WAIT_L(8); PG8_BAR; PG8_WAIT_L(0); PG8_MMA(0, 0, At, B0); PG8_BAR; PG8_SCHED;
            PG8_LDB(B1, 0, 1); PG8_STAGE(PG8_SB(0, 0), b2, voffB);
            PG8_BAR; PG8_WAIT_L(0); PG8_MMA(0, 1, At, B1); PG8_BAR;
            PG8_LDA(At, 0, 1); PG8_STAGE(PG8_SA(0, 0), a2, voffA);
            PG8_BAR; PG8_WAIT_L(0); PG8_MMA(1, 0, At, B0); PG8_BAR; PG8_SCHED;
            PG8_STAGE(PG8_SB(0, 1), b2 + hstep, voffB);
            PG8_WAIT_V(6); PG8_BAR; PG8_MMA(1, 1, At, B1); PG8_BAR;
            PG8_LDB(B0, 1, 0); PG8_SCHED; PG8_LDA(At, 1, 0); PG8_STAGE(PG8_SA(0, 1), a2 + hstep, voffA);
            PG8_WAIT_L(8); PG8_BAR; PG8_WAIT_L(0); PG8_MMA(0, 0, At, B0); PG8_BAR; PG8_SCHED;
            PG8_LDB(B1, 1, 1); PG8_STAGE(PG8_SB(1, 0), b3, voffB);
            PG8_BAR; PG8_WAIT_L(0); PG8_MMA(0, 1, At, B1); PG8_BAR;
            PG8_LDA(At, 1, 1); PG8_STAGE(PG8_SA(1, 0), a3, voffA);
            PG8_BAR; PG8_WAIT_L(0); PG8_MMA(1, 0, At, B0); PG8_BAR; PG8_SCHED;
            PG8_STAGE(PG8_SB(1, 1), b3 + hstep, voffB);
            PG8_WAIT_V(6); PG8_BAR; PG8_MMA(1, 1, At, B1); PG8_BAR;
        }
        E(acc, cur, wr, wc, fr, fq, ui);
        if (!has_next) break;
#pragma unroll
        for (int a = 0; a < 2; ++a)
#pragma unroll
            for (int b = 0; b < 2; ++b)
#pragma unroll
                for (int m = 0; m < 4; ++m)
#pragma unroll
                    for (int n = 0; n < 2; ++n) acc[a][b][m][n] = (f32x4){0.f, 0.f, 0.f, 0.f};
        cur = nxt; cA = nA; cB = nB; ++ui;
    }
    PG8_WAIT_V(0);
    if (wr == 0) PG8_BAR;
    PG8_BAR;
#undef PG8_SA
#undef PG8_SB
#undef PG8_STAGE
#undef PG8_LDA
#undef PG8_LDB
#undef PG8_MMA
#undef PG8_WAIT_V
#undef PG8_WAIT_L
#undef PG8_BAR
#undef PG8_SCHED
}
}

typedef f32x4 Acc[2][2][4][2];
struct EpiGU {
    const LAS float* rtab; bf16_t* H;
    __device__ __forceinline__ void operator()(const Acc& acc, const pg8::Unit& u, int wr, int wc, int fr, int fq, int ui) const {
        const int row0 = u.pm * 256 + wr * 64 + fr, col0 = u.pn * 128 + wc * 32 + 8 * fq;
#pragma unroll
        for (int ai = 0; ai < 2; ++ai)
#pragma unroll
            for (int m = 0; m < 4; ++m) {
                const int row = row0 + ai * 128 + m * 16;
                const float r = rtab[(ui & 7) * 256 + (row & 255)];
                const float cn = -1.44269504089f * r, r2 = r * r;
                f32x4 h0, h1;
#pragma unroll
                for (int j = 0; j < 4; ++j) {
                    const float g0 = acc[ai][0][m][0][j], g1 = acc[ai][0][m][1][j];
                    h0[j] = (g0 * acc[ai][1][m][0][j]) * r2 * fast_rcp(1.0f + fast_exp2(cn * g0));
                    h1[j] = (g1 * acc[ai][1][m][1][j]) * r2 * fast_rcp(1.0f + fast_exp2(cn * g1));
                }
                *(u32x4*)(H + (size_t)row * DFF + col0) = pack8(h0, h1);
            }
    }
};
struct EpiRes {
    bf16_t* XB; u64* ssout; float alpha;
    __device__ __forceinline__ void operator()(const Acc& acc, const pg8::Unit& u, int wr, int wc, int fr, int fq, int ui) const {
        const int row0 = u.pm * 256 + wr * 64 + fr, col0 = u.pn * 256 + wc * 32 + 8 * fq;
        u32x4 xv[2][4][2];
#pragma unroll
        for (int ai = 0; ai < 2; ++ai)
#pragma unroll
            for (int m = 0; m < 4; ++m)
#pragma unroll
                for (int bj = 0; bj < 2; ++bj) xv[ai][m][bj] = *(const u32x4*)(XB + (size_t)(row0 + ai * 128 + m * 16) * D + col0 + bj * 128);
#pragma unroll
        for (int ai = 0; ai < 2; ++ai)
#pragma unroll
            for (int m = 0; m < 4; ++m) {
                const int row = row0 + ai * 128 + m * 16;
                float sq = 0.f;
#pragma unroll
                for (int bj = 0; bj < 2; ++bj) {
                    bf16_t* xp = XB + (size_t)row * D + col0 + bj * 128;
                    const u32x4 xb = xv[ai][m][bj];
                    f32x4 x0 = (f32x4){bf16lo(xb.x), bf16hi(xb.x), bf16lo(xb.y), bf16hi(xb.y)}, x1 = (f32x4){bf16lo(xb.z), bf16hi(xb.z), bf16lo(xb.w), bf16hi(xb.w)};
                    x0 += alpha * acc[ai][bj][m][0]; x1 += alpha * acc[ai][bj][m][1];
                    *(u32x4*)xp = pack8(x0, x1);
                    sq += x0[0] * x0[0] + x0[1] * x0[1] + x0[2] * x0[2] + x0[3] * x0[3] + x1[0] * x1[0] + x1[1] * x1[1] + x1[2] * x1[2] + x1[3] * x1[3];
                }
                sq += __shfl_xor(sq, 16); sq += __shfl_xor(sq, 32);
                if (fq == 0) atomicAdd(ssout + row, (u64)(sq * SS_FX));
            }
    }
};
struct EpiQKV {
    const LAS float* rtab; bf16_t* Qb; float* out;
    __device__ __forceinline__ void operator()(const Acc& acc, const pg8::Unit& u, int wr, int wc, int fr, int fq, int ui) const {
        const int t = u.pn >> 2;
        const int row0 = u.pm * 256 + wr * 64 + fr, col0 = (u.pn & 3) * 256 + wc * 32 + 8 * fq;
        const float qs = 0.08838834764831845f * 1.44269504089f;
        bf16_t* bdst = Qb + (size_t)t * MT * D;
        const size_t foff = u.pm < 64 ? (size_t)17301504 + (size_t)(t - 1) * 16777216 : (size_t)52953088 + (size_t)(t - 1) * 524288;
        float* fdst = out + foff; const int rsub = u.pm < 64 ? 0 : MP;
#pragma unroll
        for (int ai = 0; ai < 2; ++ai)
#pragma unroll
            for (int m = 0; m < 4; ++m) {
                const int row = row0 + ai * 128 + m * 16;
                float r = rtab[(ui & 7) * 256 + (row & 255)];
                if (t == 0) r *= qs;
#pragma unroll
                for (int bj = 0; bj < 2; ++bj) {
                    const f32x4 v0 = acc[ai][bj][m][0] * r, v1 = acc[ai][bj][m][1] * r;
                    *(u32x4*)(bdst + (size_t)row * D + col0 + bj * 128) = pack8(v0, v1);
                    if (t != 0) { float* fp = fdst + (size_t)(row - rsub) * D + col0 + bj * 128; *(f32x4*)fp = v0; *(f32x4*)(fp + 4) = v1; }
                }
            }
    }
};
struct EpiRetIn {
    const LAS float* rtab; bf16_t* Qr; bf16_t* Kr; bf16_t* Vr; bf16_t* Gr;
    __device__ __forceinline__ void operator()(const Acc& acc, const pg8::Unit& u, int wr, int wc, int fr, int fq, int ui) const {
        const int pn = u.pn;
        const int row0 = u.pm * 256 + wr * 64 + fr;
        const int cc0 = wc * 32 + 8 * fq;
#pragma unroll
        for (int ai = 0; ai < 2; ++ai)
#pragma unroll
            for (int m = 0; m < 4; ++m) {
                const int row = row0 + ai * 128 + m * 16;
                const float r = rtab[(ui & 7) * 256 + (row & 255)];
                const float pos = (float)(row < MP ? (row & (SEQ - 1)) : (PAST + ((row - MP) & (DSEQ - 1))));
#pragma unroll
                for (int bj = 0; bj < 2; ++bj) {
                    f32x4 v0 = acc[ai][bj][m][0] * r, v1 = acc[ai][bj][m][1] * r;
                    const int cc = cc0 + bj * 128;
                    if (pn < 8) {
                        const float ksc = pn < 4 ? 1.0f : 0.0625f;
                        float o[8]; const float in8[8] = {v0[0], v0[1], v0[2], v0[3], v1[0], v1[1], v1[2], v1[3]};
#pragma unroll
                        for (int p = 0; p < 4; ++p) {
                            const int i = (cc >> 1) + p;
                            const float ang = fast_exp2((float)i * (-13.287712379549449f / 127.0f)) * 0.15915494309189535f;
                            const float rev = __builtin_amdgcn_fractf(pos * ang);
                            const float sn = __builtin_amdgcn_sinf(rev) * ksc, cs = __builtin_amdgcn_cosf(rev) * ksc;
                            const float x1 = in8[2 * p], x2 = in8[2 * p + 1];
                            o[2 * p] = x1 * cs - x2 * sn; o[2 * p + 1] = x2 * cs + x1 * sn;
                        }
                        u32x4 w; w.x = cvt_pk_bf16(o[0], o[1]); w.y = cvt_pk_bf16(o[2], o[3]); w.z = cvt_pk_bf16(o[4], o[5]); w.w = cvt_pk_bf16(o[6], o[7]);
                        bf16_t* dst = (pn < 4 ? Qr : Kr) + (size_t)row * D + (pn & 3) * 256 + cc;
                        *(u32x4*)dst = w;
                    } else if (pn < 16) {
                        *(u32x4*)(Vr + (size_t)row * 2048 + (pn - 8) * 256 + cc) = pack8(v0, v1);
                    } else {
#pragma unroll
                        for (int j = 0; j < 4; ++j) { v0[j] = silu_f(v0[j]); v1[j] = silu_f(v1[j]); }
                        *(u32x4*)(Gr + (size_t)row * 2048 + (pn - 16) * 256 + cc) = pack8(v0, v1);
                    }
                }
            }
    }
};

__device__ __forceinline__ unsigned gb_ld(unsigned* p) { return __hip_atomic_load(p, __ATOMIC_RELAXED, __HIP_MEMORY_SCOPE_AGENT); }
__device__ __forceinline__ unsigned gb_add(unsigned* p) { return __hip_atomic_fetch_add(p, 1u, __ATOMIC_RELAXED, __HIP_MEMORY_SCOPE_AGENT); }
__device__ __forceinline__ unsigned xcc_id() { return (unsigned)__builtin_amdgcn_s_getreg((3 << 11) | 20) & 0xFu; }
__device__ __forceinline__ void gbar(unsigned* bar, unsigned& k, unsigned G, volatile LAS unsigned* st) {
    asm volatile("s_waitcnt vmcnt(0)" ::: "memory");
    __syncthreads();
    k += 1u;
    if (threadIdx.x == 0) {
        const unsigned x = xcc_id();
        unsigned nloc = st[0], nx = st[1];
        if (nloc == 0u) {
            for (;;) {
                unsigned sum = 0u, cnt = 0u, mine = 0u;
#pragma unroll
                for (unsigned j = 0; j < 16; ++j) { const unsigned c = gb_ld(bar + 544 + j); sum += c; cnt += (c > 0u) ? 1u : 0u; mine = (j == x) ? c : mine; }
                if (sum == G) { nloc = mine; nx = cnt; break; }
                __builtin_amdgcn_s_sleep(2);
            }
            st[0] = nloc; st[1] = nx;
        }
        unsigned* sub = bar + 16 * x; unsigned* gen = bar + 256 + 16 * x; unsigned* top = bar + 512;
        const unsigned old = gb_add(sub);
        if (old + 1u == k * nloc) {
            __builtin_amdgcn_fence(__ATOMIC_RELEASE, "agent");
            asm volatile("s_waitcnt vmcnt(0)" ::: "memory");
            const unsigned ot = gb_add(top);
            if (ot + 1u != k * nx) { while (gb_ld(top) < k * nx) __builtin_amdgcn_s_sleep(1); }
            __builtin_amdgcn_fence(__ATOMIC_ACQUIRE, "agent");
            gb_add(gen);
            asm volatile("s_waitcnt vmcnt(0)" ::: "memory");
        } else {
            while (gb_ld(gen) < k) __builtin_amdgcn_s_sleep(1);
            __builtin_amdgcn_fence(__ATOMIC_ACQUIRE, "agent");
            asm volatile("s_waitcnt vmcnt(0)" ::: "memory");
        }
    }
    __syncthreads();
}

template <int K>
__device__ __forceinline__ void small_gemm_res(const bf16_t* A, const bf16_t* Bt, bf16_t* XB, u64* ssout, float alpha, LAS unsigned char* lds, int tile) {
    int tid_ = threadIdx.x; asm volatile("" : "+v"(tid_));
    const int tid = tid_, w = __builtin_amdgcn_readfirstlane(tid >> 6), lane = tid & 63, c_ = lane & 15, g = lane >> 4;
    const int row0 = MP + (tile >> 4) * 32, col0 = (tile & 15) * 64;
    constexpr int KW = K / 8, NKS = KW / 32;
    f32x4 acc[2][4];
#pragma unroll
    for (int r = 0; r < 2; ++r)
#pragma unroll
        for (int c = 0; c < 4; ++c) acc[r][c] = (f32x4){0.f, 0.f, 0.f, 0.f};
    const bf16_t* ap = A + (size_t)(row0 + c_) * K + w * KW + g * 8;
    const bf16_t* bp = Bt + (size_t)(col0 + c_) * K + w * KW + g * 8;
#pragma unroll 4
    for (int ks = 0; ks < NKS; ++ks) {
        bf16x8 a[2], b[4];
#pragma unroll
        for (int r = 0; r < 2; ++r) a[r] = *(const bf16x8*)(ap + (size_t)r * 16 * K + ks * 32);
#pragma unroll
        for (int c = 0; c < 4; ++c) b[c] = *(const bf16x8*)(bp + (size_t)c * 16 * K + ks * 32);
#pragma unroll
        for (int r = 0; r < 2; ++r)
#pragma unroll
            for (int c = 0; c < 4; ++c) acc[r][c] = mfma16(a[r], b[c], acc[r][c]);
    }
    LAS float* Pw = (LAS float*)lds;
#pragma unroll
    for (int r = 0; r < 2; ++r)
#pragma unroll
        for (int c = 0; c < 4; ++c)
#pragma unroll
            for (int j = 0; j < 4; ++j) Pw[w * 2048 + (r * 16 + 4 * g + j) * 64 + c * 16 + c_] = acc[r][c][j];
    __syncthreads();
    {
        const int m = tid >> 4, n4 = (tid & 15) * 4;
        f32x4 v = (f32x4){0.f, 0.f, 0.f, 0.f};
#pragma unroll
        for (int ww = 0; ww < 8; ++ww) v += *(const LAS f32x4*)(Pw + ww * 2048 + m * 64 + n4);
        const int row = row0 + m;
        bf16_t* xp = XB + (size_t)row * D + col0 + n4;
        const u32x2 xb = *(const u32x2*)xp;
        f32x4 x = (f32x4){bf16lo(xb.x), bf16hi(xb.x), bf16lo(xb.y), bf16hi(xb.y)}; x += alpha * v;
        u32x2 wv; wv.x = cvt_pk_bf16(x[0], x[1]); wv.y = cvt_pk_bf16(x[2], x[3]);
        *(u32x2*)xp = wv;
        float sq = x[0] * x[0] + x[1] * x[1] + x[2] * x[2] + x[3] * x[3];
        sq += __shfl_xor(sq, 1); sq += __shfl_xor(sq, 2); sq += __shfl_xor(sq, 4); sq += __shfl_xor(sq, 8);
        if ((tid & 15) == 0) atomicAdd(ssout + row, (u64)(sq * SS_FX));
    }
    __syncthreads();
}

__device__ __forceinline__ void build_rtab(LAS unsigned char* lds, const pg8::StaticOrder& S, const u64* ss) {
    int tid_ = threadIdx.x; asm volatile("" : "+v"(tid_));
    const int tid = tid_;
    LAS float* rtab = (LAS float*)(lds + LDS_RTAB);
    u64 v[4]; bool ok[4];
#pragma unroll
    for (int j = 0; j < 4; ++j) {
        const int idx = tid + 512 * j, ui = idx >> 8; pg8::Unit u;
        ok[j] = S.next(ui, u);
        v[j] = ok[j] ? ss[u.pm * 256 + (idx & 255)] : 0ull;
    }
#pragma unroll
    for (int j = 0; j < 4; ++j) if (ok[j]) rtab[tid + 512 * j] = rsqrtf((float)v[j] * (SS_INV / 1024.0f) + 1e-6f);
    __syncthreads();
}

__device__ __forceinline__ void prep_phase(const Params& P, LAS unsigned char* lds) {
    int tid_ = threadIdx.x; asm volatile("" : "+v"(tid_));
    const int tid = tid_, G = gridDim.x, bid = blockIdx.x;
    unsigned char* ws = P.ws;
    {
        unsigned* ctl = (unsigned*)(ws + WS_CTL);
        u64* ss = (u64*)(ws + WS_SS);
        const size_t nz = 6ull * MT;
        for (size_t i = (size_t)bid * NTHREADS + tid; i < nz; i += (size_t)G * NTHREADS) ss[MT + i] = 0ull;
        if (bid == 0) { ctl[tid] = 0u; ctl[tid + 512] = 0u; }
    }
    {
        bf16_t* XB = (bf16_t*)(ws + WS_XB); u64* ss0 = (u64*)(ws + WS_SS);
        const int wave = tid >> 6, lane = tid & 63;
        for (int row = bid * 8 + wave; row < MT; row += G * 8) {
            const float* src = row < MP ? P.in[0] + (size_t)row * D : P.in[1] + (size_t)(row - MP) * D;
            float sq = 0.f;
#pragma unroll
            for (int i = 0; i < 2; ++i) {
                const int c = i * 512 + lane * 8;
                const f32x4 a = *(const f32x4*)(src + c), b = *(const f32x4*)(src + c + 4);
                *(u32x4*)(XB + (size_t)row * D + c) = pack8(a, b);
                sq += a[0] * a[0] + a[1] * a[1] + a[2] * a[2] + a[3] * a[3] + b[0] * b[0] + b[1] * b[1] + b[2] * b[2] + b[3] * b[3];
            }
#pragma unroll
            for (int o = 32; o >= 1; o >>= 1) sq += __shfl_xor(sq, o);
            if (lane == 0) ss0[row] = (u64)(sq * SS_FX);
        }
    }
    {
        constexpr int NT_TOTAL = 11520;
        f32x4 ra, rb; float rg = 1.f; bf16_t* rdp = nullptr;
        auto fetch = [&](int tile) {
            const float* src; const float* gain = nullptr; bf16_t* dst; int K, N, rowadd = 0, interleave = 0, lt;
            if (tile < 5632) {
                const int job = tile / 704; lt = tile % 704; const int f = job & 3, up = job >> 2, layer = f >> 1;
                K = 1024; N = 2816; interleave = 1; rowadd = up * 128;
                src = P.in[(f & 1) ? (up ? 21 : 20) : (up ? 7 : 6)] + (size_t)layer * 1024 * 2816;
                gain = P.in[(f & 1) ? 19 : 5] + layer * 1024;
                dst = (bf16_t*)(ws + WS_WGU + f * WGU_BYTES);
            } else if (tile < 8448) {
                const int f = (tile - 5632) / 704; lt = (tile - 5632) % 704; const int layer = f >> 1;
                K = 2816; N = 1024; src = P.in[(f & 1) ? 22 : 8] + (size_t)layer * 2816 * 1024; dst = (bf16_t*)(ws + WS_WD + f * WD_BYTES);
            } else if (tile < 9216) { lt = tile - 8448; K = 1024; N = 3072; src = P.in[10]; gain = P.in[9]; dst = (bf16_t*)(ws + WS_WQKV); }
            else if (tile < 9472) { lt = tile - 9216; K = 1024; N = 1024; src = P.in[16]; dst = (bf16_t*)(ws + WS_WO); }
            else if (tile < 11008) { lt = tile - 9472; K = 1024; N = 6144; src = P.in[17]; gain = P.in[9] + 1024; dst = (bf16_t*)(ws + WS_WRIN); }
            else { lt = tile - 11008; K = 2048; N = 1024; src = P.in[18]; dst = (bf16_t*)(ws + WS_WRO); }
            const int ntn = N / 64, k0 = (lt / ntn) * 64, n0 = (lt % ntn) * 64;
            const int k = tid >> 3, n8 = (tid & 7) * 8;
            const float* sp = src + (size_t)(k0 + k) * N + n0 + n8;
            ra = *(const f32x4*)sp; rb = *(const f32x4*)(sp + 4);
            rg = gain ? gain[k0 + k] : 1.0f;
            const int ng = n0 + (tid >> 3);
            const int drow = interleave ? ((ng >> 7) * 256 + rowadd + (ng & 127)) : ng;
            rdp = dst + (size_t)drow * K + k0 + (tid & 7) * 8;
        };
        int tile = bid, it = 0;
        if (tile < NT_TOTAL) fetch(tile);
        for (; tile < NT_TOTAL; tile += G, ++it) {
            LAS bf16_t* T = (LAS bf16_t*)(lds + (it & 1) * 16384);
            {
                const int k = tid >> 3, n8 = (tid & 7) * 8;
                *(LAS u32x4*)(T + k * 72 + n8) = pack8(ra * rg, rb * rg);
            }
            bf16_t* dp = rdp;
            LDS_BARRIER();
            if (tile + G < NT_TOTAL) fetch(tile + G);
            {
                const int n = tid >> 3, k8 = (tid & 7) * 8;
                unsigned w[4];
#pragma unroll
                for (int j = 0; j < 4; ++j) { const unsigned lo = T[(k8 + 2 * j) * 72 + n], hi = T[(k8 + 2 * j + 1) * 72 + n]; w[j] = lo | (hi << 16); }
                u32x4 wv; wv.x = w[0]; wv.y = w[1]; wv.z = w[2]; wv.w = w[3];
                *(u32x4*)dp = wv;
            }
        }
        LDS_BARRIER();
    }
}

constexpr int ATT_ITEMS = 64 + 1024;
__device__ __forceinline__ void attn_item(const Params& P, LAS unsigned char* lds, int item, float lam) {
    int tid_ = threadIdx.x; asm volatile("" : "+v"(tid_));
    const int tid = tid_, w = __builtin_amdgcn_readfirstlane(tid >> 6), lane = tid & 63, c_ = lane & 15, g = lane >> 4;
    const int map = w >> 2, rg = w & 3;
    unsigned char* ws = P.ws;
    const bf16_t* Qb = (const bf16_t*)(ws + WS_SCR); const bf16_t* Kb = Qb + (size_t)MT * D; const bf16_t* Vb = Kb + (size_t)MT * D; bf16_t* Ob = (bf16_t*)(Vb + (size_t)MT * D);
    int b, h, qrow0, nkt, kvrow0; bool sample;
    if (item < 64) { sample = true; b = item >> 2; h = item & 3; qrow0 = MP + b * DSEQ; nkt = 33; kvrow0 = 0; }
    else { sample = false; const int idx = item - 64; const int qb = 63 - (idx >> 4); const int bh = idx & 15; b = bh >> 2; h = bh & 3; qrow0 = b * SEQ + qb * 64; nkt = qb + 1; kvrow0 = b * SEQ; }
    const bool active = sample ? (rg < 2) : true;
    bf16x8 qf[4];
    {
        const int qrow = qrow0 + (active ? rg * 16 : 0) + c_;
        const bf16_t* qp = Qb + (size_t)qrow * D + h * 256 + map * 128 + g * 8;
#pragma unroll
        for (int ks = 0; ks < 4; ++ks) qf[ks] = *(const bf16x8*)(qp + ks * 32);
    }
    f32x4 o[16];
#pragma unroll
    for (int i = 0; i < 16; ++i) o[i] = (f32x4){0.f, 0.f, 0.f, 0.f};
    float mrun = -1e30f, lrun = 0.f;
    u32x4 pre[8]; f32x4 raw[16];
    const float* ck = P.in[2]; const float* cv = P.in[3];
    auto load_tile = [&](int kt) {
#pragma unroll
        for (int i = 0; i < 8; ++i) {
            const int pid = tid + 512 * (i & 3), isV = i >> 2, key = pid >> 5, chunk = pid & 31;
            if (!sample) {
                const bf16_t* sp = (isV ? Vb : Kb) + (size_t)(kvrow0 + kt * 64 + key) * D + h * 256 + chunk * 8;
                pre[i] = *(const u32x4*)sp;
            } else if (kt < 32) {
                const float* sp = (isV ? cv : ck) + ((size_t)(b * PAST + kt * 64 + key)) * D + h * 256 + chunk * 8;
                raw[2 * i] = *(const f32x4*)sp; raw[2 * i + 1] = *(const f32x4*)(sp + 4);
            } else {
                if (key < 32) { const bf16_t* sp = (isV ? Vb : Kb) + (size_t)(MP + b * DSEQ + key) * D + h * 256 + chunk * 8; pre[i] = *(const u32x4*)sp; }
                else pre[i] = (u32x4){0u, 0u, 0u, 0u};
            }
        }
    };
    load_tile(0);
    const int q4 = c_ >> 2, p4 = c_ & 3, sw = (4 * g + q4) & 7;
    for (int kt = 0; kt < nkt; ++kt) {
        LDS_BARRIER();
#pragma unroll
        for (int i = 0; i < 8; ++i) {
            const int pid = tid + 512 * (i & 3), isV = i >> 2, key = pid >> 5, chunk = pid & 31;
            int off;
            if (!isV) off = (chunk >> 4) * 16384 + 256 * key + 16 * ((chunk & 15) ^ (key & 15));
            else off = 32768 + (chunk >> 4) * 16384 + 256 * key + 32 * (((chunk & 15) >> 1) ^ (key & 7)) + 16 * (chunk & 1);
            *(LAS u32x4*)(lds + off) = (sample && kt < 32) ? pack8(raw[2 * i], raw[2 * i + 1]) : pre[i];
        }
        LDS_BARRIER();
        if (kt + 1 < nkt) load_tile(kt + 1);
        if (active) {
            f32x4 s[4];
#pragma unroll
            for (int t = 0; t < 4; ++t) {
                s[t] = (f32x4){0.f, 0.f, 0.f, 0.f};
#pragma unroll
                for (int ks = 0; ks < 4; ++ks) {
                    const bf16x8 kf = *(const LAS bf16x8*)(lds + map * 16384 + 256 * (16 * t + c_) + 16 * ((4 * ks + g) ^ c_));
                    s[t] = mfma16(kf, qf[ks], s[t]);
                }
            }
            if (sample && kt == 32) { s[2] = (f32x4){-1e30f, -1e30f, -1e30f, -1e30f}; s[3] = s[2]; }
            float mx = -1e30f;
#pragma unroll
            for (int t = 0; t < 4; ++t)
#pragma unroll
                for (int j = 0; j < 4; ++j) mx = fmaxf(mx, s[t][j]);
            mx = fmaxf(mx, __shfl_xor(mx, 16)); mx = fmaxf(mx, __shfl_xor(mx, 32));
            const float mnew = fmaxf(mrun, mx), alpha = fast_exp2(mrun - mnew);
            mrun = mnew;
            float lsum = 0.f;
#pragma unroll
            for (int t = 0; t < 4; ++t)
#pragma unroll
                for (int j = 0; j < 4; ++j) { s[t][j] = fast_exp2(s[t][j] - mnew); lsum += s[t][j]; }
            lrun = lrun * alpha + lsum;
#pragma unroll
            for (int i = 0; i < 16; ++i) o[i] *= alpha;
            bf16x8 pf[2];
            pf[0] = as_bf16x8(pack8(s[0], s[1])); pf[1] = as_bf16x8(pack8(s[2], s[3]));
#pragma unroll
            for (int dvt = 0; dvt < 16; ++dvt) {
#pragma unroll
                for (int s2 = 0; s2 < 2; ++s2) {
                    const int base = 32768 + (dvt >> 3) * 16384 + 256 * (32 * s2 + 4 * g + q4) + 32 * ((dvt & 7) ^ sw) + 8 * p4;
                    const s16x4 a0 = tr_read(lds + base), a1 = tr_read(lds + base + 256 * 16);
                    o[dvt] = mfma16(cat8(a0, a1), pf[s2], o[dvt]);
                }
            }
        }
    }
    LDS_BARRIER();
    float lt = lrun + __shfl_xor(lrun, 16); lt += __shfl_xor(lt, 32);
    const float inv = 1.0f / lt;
    LAS float* X2 = (LAS float*)lds;
    if (active && map == 1) {
        const float sc = inv * lam;
#pragma unroll
        for (int dvt = 0; dvt < 16; ++dvt) *(LAS f32x4*)(X2 + (rg * 16 + c_) * 260 + 16 * dvt + 4 * g) = o[dvt] * sc;
    }
    LDS_BARRIER();
    if (active && map == 0) {
        float sq = 0.f;
#pragma unroll
        for (int dvt = 0; dvt < 16; ++dvt) {
            const f32x4 x2 = *(const LAS f32x4*)(X2 + (rg * 16 + c_) * 260 + 16 * dvt + 4 * g);
            o[dvt] = o[dvt] * inv - x2;
            sq += o[dvt][0] * o[dvt][0] + o[dvt][1] * o[dvt][1] + o[dvt][2] * o[dvt][2] + o[dvt][3] * o[dvt][3];
        }
        sq += __shfl_xor(sq, 16); sq += __shfl_xor(sq, 32);
        const float r = rsqrtf(sq * (1.0f / 256.0f) + 1e-5f) * 0.8f;
        bf16_t* op = Ob + (size_t)(qrow0 + rg * 16 + c_) * D + h * 256 + 4 * g;
#pragma unroll
        for (int dvt = 0; dvt < 16; ++dvt) {
            const f32x4 gn = *(const LAS f32x4*)(lds + LDS_RTAB + (16 * dvt + 4 * g) * 4);
            const f32x4 v = o[dvt] * r * gn;
            u32x2 wv; wv.x = cvt_pk_bf16(v[0], v[1]); wv.y = cvt_pk_bf16(v[2], v[3]);
            *(u32x2*)(op + 16 * dvt) = wv;
        }
    }
}

constexpr int ATTP_ITEMS = 512;
__device__ __forceinline__ void attn_item_p(const Params& P, LAS unsigned char* lds, int idx, float lam) {
    int tid_ = threadIdx.x; asm volatile("" : "+v"(tid_));
    const int tid = tid_, w = __builtin_amdgcn_readfirstlane(tid >> 6), lane = tid & 63, c_ = lane & 15, g = lane >> 4;
    const int map = w >> 2, rg = w & 3;
    unsigned char* ws = P.ws;
    const bf16_t* Qb = (const bf16_t*)(ws + WS_SCR); const bf16_t* Kb = Qb + (size_t)MT * D; const bf16_t* Vb = Kb + (size_t)MT * D; bf16_t* Ob = (bf16_t*)(Vb + (size_t)MT * D);
    const int qb = 31 - (idx >> 4), bh = idx & 15, b = bh >> 2, h = bh & 3;
    const int qrow0 = b * SEQ + qb * 128, nkt = 2 * qb + 2, kvrow0 = b * SEQ;
    const int nkt_w = (rg >= 2) ? nkt : nkt - 1;
    const int region = w >> 1;
    const bf16_t* dsrc = (region < 2 ? Kb : Vb) + (size_t)kvrow0 * D + h * 256 + (region & 1) * 128;
    unsigned dvoff[4];
#pragma unroll
    for (int q = 0; q < 4; ++q) {
        const int k15 = 4 * q + g, k7 = k15 & 7;
        const int col = (region < 2) ? ((c_ ^ k15) * 8) : ((2 * ((c_ >> 1) ^ k7) + (c_ & 1)) * 8);
        dvoff[q] = (unsigned)(g * D + col) * 2u;
    }
#define ATTP_DMA(kt, buf) do { _Pragma("unroll") for (int j = 0; j < 8; ++j) { \
        const int r16 = 8 * (w & 1) + j; \
        const char* gb = (const char*)dsrc + (size_t)((kt) * 64 + 4 * r16) * (D * 2); \
        __builtin_amdgcn_global_load_lds((const unsigned*)(gb + dvoff[j & 3]), (LAS unsigned*)(lds + (buf) * 65536 + region * 16384 + r16 * 1024), 16, 0, 0); } } while (0)
    ATTP_DMA(0, 0);
    bf16x8 qf[2][4];
#pragma unroll
    for (int cg2 = 0; cg2 < 2; ++cg2) {
        const bf16_t* qp = Qb + (size_t)(qrow0 + rg * 32 + cg2 * 16 + c_) * D + h * 256 + map * 128 + g * 8;
#pragma unroll
        for (int ks = 0; ks < 4; ++ks) qf[cg2][ks] = *(const bf16x8*)(qp + ks * 32);
    }
    f32x4 o[2][16];
#pragma unroll
    for (int cg2 = 0; cg2 < 2; ++cg2)
#pragma unroll
        for (int i = 0; i < 16; ++i) o[cg2][i] = (f32x4){0.f, 0.f, 0.f, 0.f};
    float mrun[2] = {-1e30f, -1e30f}, lrun[2] = {0.f, 0.f};
    const int q4 = c_ >> 2, p4 = c_ & 3, sw = (4 * g + q4) & 7;
    asm volatile("s_waitcnt vmcnt(0)" ::: "memory");
    LDS_BARRIER();
    for (int kt = 0; kt < nkt; ++kt) {
        const int bo = (kt & 1) * 65536;
        if (kt + 1 < nkt) { if (kt & 1) ATTP_DMA(kt + 1, 0); else ATTP_DMA(kt + 1, 1); }
        if (kt < nkt_w) {
#pragma unroll
            for (int s2 = 0; s2 < 2; ++s2) {
                int cl = c_; const int swl = sw; asm volatile("" : "+v"(cl));
                f32x4 s[2][2];
                {
                    const int kb0 = bo + map * 16384 + 256 * (32 * s2 + cl);
                    bf16x8 kf = *(const LAS bf16x8*)(lds + kb0 + 16 * (g ^ cl));
                    __builtin_amdgcn_s_setprio(1);
#pragma unroll
                    for (int it = 0; it < 8; ++it) {
                        const int t2 = it >> 2, ks = it & 3;
                        bf16x8 kn = kf;
                        if (it < 7) { const int t2n = (it + 1) >> 2, ksn = (it + 1) & 3; kn = *(const LAS bf16x8*)(lds + kb0 + 4096 * t2n + 16 * ((4 * ksn + g) ^ cl)); }
                        if (ks == 0) { s[0][t2] = (f32x4){0.f, 0.f, 0.f, 0.f}; s[1][t2] = s[0][t2]; }
                        s[0][t2] = mfma16(kf, qf[0][ks], s[0][t2]);
                        s[1][t2] = mfma16(kf, qf[1][ks], s[1][t2]);
                        kf = kn;
                        __builtin_amdgcn_sched_barrier(0);
                    }
                    __builtin_amdgcn_s_setprio(0);
                }
                bf16x8 pf[2];
#pragma unroll
                for (int cg2 = 0; cg2 < 2; ++cg2) {
                    float mx = -1e30f;
#pragma unroll
                    for (int t2 = 0; t2 < 2; ++t2)
#pragma unroll
                        for (int j = 0; j < 4; ++j) mx = fmaxf(mx, s[cg2][t2][j]);
                    if (__builtin_amdgcn_ballot_w64(mx > mrun[cg2] + 8.0f) != 0ull) {
                        mx = fmaxf(mx, __shfl_xor(mx, 16)); mx = fmaxf(mx, __shfl_xor(mx, 32));
                        const float mnew = fmaxf(mrun[cg2], mx), alpha = fast_exp2(mrun[cg2] - mnew);
                        mrun[cg2] = mnew;
                        lrun[cg2] *= alpha;
#pragma unroll
                        for (int i = 0; i < 16; ++i) o[cg2][i] *= alpha;
                    }
                    const float mcur = mrun[cg2];
                    float lsum = 0.f;
#pragma unroll
                    for (int t2 = 0; t2 < 2; ++t2)
#pragma unroll
                        for (int j = 0; j < 4; ++j) { s[cg2][t2][j] = fast_exp2(s[cg2][t2][j] - mcur); lsum += s[cg2][t2][j]; }
                    lrun[cg2] += lsum;
                    pf[cg2] = as_bf16x8(pack8(s[cg2][0], s[cg2][1]));
                }
                {
                    const int vb0 = bo + 32768 + 256 * (32 * s2 + 4 * g + q4) + 8 * p4;
                    s16x4 a0 = tr_read(lds + vb0 + 32 * (0 ^ swl)), a1 = tr_read(lds + vb0 + 32 * (0 ^ swl) + 256 * 16);
                    __builtin_amdgcn_s_setprio(1);
#pragma unroll
                    for (int dvt = 0; dvt < 16; ++dvt) {
                        s16x4 b0 = a0, b1 = a1;
                        if (dvt < 15) {
                            const int nb = vb0 + ((dvt + 1) >> 3) * 16384 + 32 * (((dvt + 1) & 7) ^ swl);
                            b0 = tr_read(lds + nb); b1 = tr_read(lds + nb + 256 * 16);
                        }
                        const bf16x8 vf = cat8(a0, a1);
                        o[0][dvt] = mfma16(vf, pf[0], o[0][dvt]);
                        o[1][dvt] = mfma16(vf, pf[1], o[1][dvt]);
                        a0 = b0; a1 = b1;
                        __builtin_amdgcn_sched_barrier(0);
                    }
                    __builtin_amdgcn_s_setprio(0);
                }
            }
        }
        asm volatile("s_waitcnt vmcnt(0)" ::: "memory");
        LDS_BARRIER();
    }
#undef ATTP_DMA
    float inv[2];
#pragma unroll
    for (int cg2 = 0; cg2 < 2; ++cg2) { float lt = lrun[cg2] + __shfl_xor(lrun[cg2], 16); lt += __shfl_xor(lt, 32); inv[cg2] = 1.0f / lt; }
    LAS float* X2 = (LAS float*)lds;
    float sq[2] = {0.f, 0.f};
#pragma unroll
    for (int hf = 0; hf < 2; ++hf) {
        if (map == 1) {
#pragma unroll
            for (int cg2 = 0; cg2 < 2; ++cg2)
#pragma unroll
                for (int d8 = 0; d8 < 8; ++d8) *(LAS f32x4*)(X2 + (rg * 32 + cg2 * 16 + c_) * 132 + 16 * d8 + 4 * g) = o[cg2][8 * hf + d8] * (inv[cg2] * lam);
        }
        LDS_BARRIER();
        if (map == 0) {
#pragma unroll
            for (int cg2 = 0; cg2 < 2; ++cg2)
#pragma unroll
                for (int d8 = 0; d8 < 8; ++d8) {
                    const f32x4 x2 = *(const LAS f32x4*)(X2 + (rg * 32 + cg2 * 16 + c_) * 132 + 16 * d8 + 4 * g);
                    f32x4 v = o[cg2][8 * hf + d8] * inv[cg2] - x2;
                    o[cg2][8 * hf + d8] = v;
                    sq[cg2] += v[0] * v[0] + v[1] * v[1] + v[2] * v[2] + v[3] * v[3];
                }
        }
        LDS_BARRIER();
    }
    if (map == 0) {
#pragma unroll
        for (int cg2 = 0; cg2 < 2; ++cg2) {
            float q2 = sq[cg2]; q2 += __shfl_xor(q2, 16); q2 += __shfl_xor(q2, 32);
            const float r = rsqrtf(q2 * (1.0f / 256.0f) + 1e-5f) * 0.8f;
            bf16_t* op = Ob + (size_t)(qrow0 + rg * 32 + cg2 * 16 + c_) * D + h * 256 + 4 * g;
#pragma unroll
            for (int dvt = 0; dvt < 16; ++dvt) {
                const f32x4 gn = *(const LAS f32x4*)(lds + LDS_RTAB + (16 * dvt + 4 * g) * 4);
                const f32x4 v = o[cg2][dvt] * r * gn;
                u32x2 wv; wv.x = cvt_pk_bf16(v[0], v[1]); wv.y = cvt_pk_bf16(v[2], v[3]);
                *(u32x2*)(op + 16 * dvt) = wv;
            }
        }
    }
}
__device__ __forceinline__ void attn_phase(const Params& P, LAS unsigned char* lds) {
    const int tid = threadIdx.x;
    LAS unsigned* misc = (LAS unsigned*)(lds + LDS_MISC);
    unsigned* ctr = (unsigned*)(P.ws + WS_CTL);
    if (tid < 64) {
        const float a = P.in[11][tid] * P.in[12][tid] + P.in[11][tid + 64] * P.in[12][tid + 64];
        const float b = P.in[13][tid] * P.in[14][tid] + P.in[13][tid + 64] * P.in[14][tid + 64];
        float sa = a, sb = b;
#pragma unroll
        for (int o = 32; o >= 1; o >>= 1) { sa += __shfl_xor(sa, o); sb += __shfl_xor(sb, o); }
        if (tid == 0) ((LAS float*)misc)[1] = expf(sa) - expf(sb) + 0.2f;
    }
    __syncthreads();
    if (tid < 64) *(LAS f32x4*)(lds + LDS_RTAB + tid * 16) = *(const f32x4*)(P.in[15] + tid * 4);
    __syncthreads();
    const float lam = ((LAS float*)misc)[1];
    for (;;) {
        __syncthreads();
        if (tid == 0) misc[0] = atomicAdd(ctr, 1u);
        __syncthreads();
        const int item = (int)misc[0];
        if (item >= 64 + ATTP_ITEMS) break;
        if (item < 288) attn_item_p(P, lds, item, lam);
        else if (item < 352) attn_item(P, lds, item - 288, lam);
        else attn_item_p(P, lds, item - 64, lam);
    }
}

constexpr int RET_ITEMS = 256 + 1024;
constexpr int R_QS = 0, R_KS = 32768, R_VS = 65536, R_VD = 69632, R_PM = 73728, R_ST = 81920;

constexpr int RETP_ITEMS = 1024 + 64;
__device__ __forceinline__ void retp_item(const Params& P, LAS unsigned char* lds, int item) {
    int tid_ = threadIdx.x; asm volatile("" : "+v"(tid_));
    const int tid = tid_, w = __builtin_amdgcn_readfirstlane(tid >> 6), lane = tid & 63, c_ = lane & 15, g = lane >> 4;
    unsigned char* ws = P.ws;
    const bf16_t* Qr = (const bf16_t*)(ws + WS_SCR); const bf16_t* Kr = Qr + (size_t)MT * D;
    int h, row0, L;
    if (item < 1024) { const int bh = item >> 6, ci = item & 63; h = bh & 3; row0 = (bh >> 2) * SEQ + ci * 64; L = 64; }
    else { const int bh = item - 1024; h = bh & 3; row0 = MP + (bh >> 2) * DSEQ; L = 32; }
    const float lg2 = __log2f(1.0f - fast_exp2((float)(-5 - h)));
    u32x4 pq[4], pk[4];
#pragma unroll
    for (int i = 0; i < 4; ++i) {
        const int pid = tid + 512 * i, tok = pid >> 5, chunk = pid & 31;
        if (tok < L) { const size_t off = (size_t)(row0 + tok) * D + h * 256 + chunk * 8; pq[i] = *(const u32x4*)(Qr + off); pk[i] = *(const u32x4*)(Kr + off); }
        else { pq[i] = (u32x4){0u, 0u, 0u, 0u}; pk[i] = pq[i]; }
    }
    LDS_BARRIER();
#pragma unroll
    for (int i = 0; i < 4; ++i) {
        const int pid = tid + 512 * i, tok = pid >> 5, chunk = pid & 31;
        const int off = tok * 512 + 16 * (chunk ^ (tok & 15));
        *(LAS u32x4*)(lds + R_QS + off) = pq[i]; *(LAS u32x4*)(lds + R_KS + off) = pk[i];
    }
    LDS_BARRIER();
    {
        const int it = w >> 1, jt0 = 2 * (w & 1);
        f32x4 pa[2] = {(f32x4){0.f, 0.f, 0.f, 0.f}, (f32x4){0.f, 0.f, 0.f, 0.f}};
#pragma unroll
        for (int ks = 0; ks < 8; ++ks) {
            const bf16x8 qa = *(const LAS bf16x8*)(lds + R_QS + (16 * it + c_) * 512 + 16 * ((4 * ks + g) ^ c_));
#pragma unroll
            for (int u = 0; u < 2; ++u) {
                const bf16x8 kb = *(const LAS bf16x8*)(lds + R_KS + (16 * (jt0 + u) + c_) * 512 + 16 * ((4 * ks + g) ^ c_));
                pa[u] = mfma16(qa, kb, pa[u]);
            }
        }
#pragma unroll
        for (int u = 0; u < 2; ++u)
#pragma unroll
            for (int j = 0; j < 4; ++j) {
                const int i = 16 * it + 4 * g + j, jj = 16 * (jt0 + u) + c_;
                const float dm = (i >= jj) ? fast_exp2((float)(i - jj) * lg2) : 0.f;
                const unsigned pkd = cvt_pk_bf16(pa[u][j] * dm, 0.f);
                *(LAS bf16_t*)(lds + R_PM + i * 128 + 16 * ((jj >> 3) ^ (i & 7)) + (jj & 7) * 2) = (bf16_t)(pkd & 0xffffu);
            }
    }
    LDS_BARRIER();
    *(u32x4*)(ws + WS_PG + (size_t)item * 8192 + tid * 16) = *(const LAS u32x4*)(lds + R_PM + tid * 16);
}
__device__ __forceinline__ void ret_item(const Params& P, LAS unsigned char* lds, int item) {
    int tid_ = threadIdx.x; asm volatile("" : "+v"(tid_));
    const int tid = tid_, w = __builtin_amdgcn_readfirstlane(tid >> 6), lane = tid & 63, c_ = lane & 15, g = lane >> 4;
    const int q4 = c_ >> 2, p4 = c_ & 3;
    unsigned char* ws = P.ws;
    const bf16_t* Qr = (const bf16_t*)(ws + WS_SCR); const bf16_t* Kr = Qr + (size_t)MT * D; bf16_t* Vr = (bf16_t*)(Kr + (size_t)MT * D);
    float* rssp = (float*)(ws + WS_RSSP);
    int b, h, sl, row0, nch, L, pitem0; const float* sinit = nullptr; float* sout;
    if (item < 256) { const int bh = item >> 4; b = bh >> 2; h = bh & 3; sl = item & 15; row0 = b * SEQ; nch = 64; L = 64; pitem0 = bh * 64;
        sout = P.out + 50855936 + ((size_t)(b * 4 + h) * 256) * 512 + sl * 32; }
    else { const int it2 = item - 256; const int bh = it2 >> 4; b = bh >> 2; h = bh & 3; sl = it2 & 15; row0 = MP + b * DSEQ; nch = 1; L = 32; pitem0 = 1024 + bh;
        sinit = P.in[4] + ((size_t)(b * 4 + h) * 256) * 512 + sl * 32; sout = P.out + 54001664 + ((size_t)(b * 4 + h) * 256) * 512 + sl * 32; }
    const float lg2 = __log2f(1.0f - fast_exp2((float)(-5 - h)));
    f32x4 S[2][2];
#pragma unroll
    for (int dt = 0; dt < 2; ++dt)
#pragma unroll
        for (int et = 0; et < 2; ++et) {
#pragma unroll
            for (int j = 0; j < 4; ++j) S[dt][et][j] = sinit ? sinit[(size_t)(32 * w + 16 * dt + 4 * g + j) * 512 + 16 * et + c_] : 0.f;
        }
    auto write_st = [&]() {
#pragma unroll
        for (int dt = 0; dt < 2; ++dt)
#pragma unroll
            for (int et = 0; et < 2; ++et) {
                const int e = 16 * et + c_;
                u32x2 wv; wv.x = cvt_pk_bf16(S[dt][et][0], S[dt][et][1]); wv.y = cvt_pk_bf16(S[dt][et][2], S[dt][et][3]);
                *(LAS u32x2*)(lds + R_ST + e * 512 + 16 * ((4 * w + 2 * dt + (g >> 1)) ^ (e & 15)) + 8 * (g & 1)) = wv;
            }
    };
    u32x4 pqA[4], pkA[4], pvA, ppA, pqB[4], pkB[4], pvB, ppB;
    auto load_chunk = [&](int ci, u32x4 (&pq)[4], u32x4 (&pk)[4], u32x4& pv, u32x4& pp) {
        pp = *(const u32x4*)(ws + WS_PG + (size_t)(pitem0 + ci) * 8192 + tid * 16);
#pragma unroll
        for (int i = 0; i < 4; ++i) {
            const int pid = tid + 512 * i, tok = pid >> 5, chunk = pid & 31;
            if (tok < L) { const size_t off = (size_t)(row0 + ci * 64 + tok) * D + h * 256 + chunk * 8; pq[i] = *(const u32x4*)(Qr + off); pk[i] = *(const u32x4*)(Kr + off); }
            else { pq[i] = (u32x4){0u, 0u, 0u, 0u}; pk[i] = pq[i]; }
        }
        if (tid < 256) { const int tok = tid >> 2, chunk = tid & 3;
            if (tok < L) pv = *(const u32x4*)(Vr + (size_t)(row0 + ci * 64 + tok) * 2048 + h * 512 + sl * 32 + chunk * 8); else pv = (u32x4){0u, 0u, 0u, 0u}; }
    };
    auto stage_chunk = [&](const u32x4 (&pq)[4], const u32x4 (&pk)[4], const u32x4& pv, const u32x4& pp) {
#pragma unroll
        for (int i = 0; i < 4; ++i) {
            const int pid = tid + 512 * i, tok = pid >> 5, chunk = pid & 31;
            const int off = tok * 512 + 16 * (chunk ^ (tok & 15));
            *(LAS u32x4*)(lds + R_QS + off) = pq[i]; *(LAS u32x4*)(lds + R_KS + off) = pk[i];
        }
        *(LAS u32x4*)(lds + R_PM + tid * 16) = pp;
        if (tid < 256) { const int tok = tid >> 2, chunk = tid & 3;
            *(LAS u32x4*)(lds + R_VS + tok * 64 + chunk * 16) = pv;
            const float dk = fast_exp2((float)(L - 1 - tok) * lg2);
            u32x4 d; d.x = cvt_pk_bf16(bf16lo(pv.x) * dk, bf16hi(pv.x) * dk); d.y = cvt_pk_bf16(bf16lo(pv.y) * dk, bf16hi(pv.y) * dk);
            d.z = cvt_pk_bf16(bf16lo(pv.z) * dk, bf16hi(pv.z) * dk); d.w = cvt_pk_bf16(bf16lo(pv.w) * dk, bf16hi(pv.w) * dk);
            *(LAS u32x4*)(lds + R_VD + tok * 64 + chunk * 16) = d; }
    };
    const float sdec = fast_exp2((float)L * lg2);
    auto compute_chunk = [&](int ci) {
        {
#pragma unroll
            for (int dt = 0; dt < 2; ++dt)
#pragma unroll
                for (int et = 0; et < 2; ++et) S[dt][et] *= sdec;
#pragma unroll
            for (int ks2 = 0; ks2 < 2; ++ks2) {
                bf16x8 vb[2];
#pragma unroll
                for (int et = 0; et < 2; ++et) {
                    const int j0 = 32 * ks2 + 4 * g + q4;
                    const s16x4 a0 = tr_read(lds + R_VD + j0 * 64 + (16 * et + 4 * p4) * 2), a1 = tr_read(lds + R_VD + (j0 + 16) * 64 + (16 * et + 4 * p4) * 2);
                    vb[et] = cat8(a0, a1);
                }
#pragma unroll
                for (int dt = 0; dt < 2; ++dt) {
                    const int j0 = 32 * ks2 + 4 * g + q4, j1 = j0 + 16;
                    const int chunk = 4 * w + 2 * dt + (p4 >> 1);
                    const s16x4 a0 = tr_read(lds + R_KS + j0 * 512 + 16 * (chunk ^ (j0 & 15)) + 8 * (p4 & 1));
                    const s16x4 a1 = tr_read(lds + R_KS + j1 * 512 + 16 * (chunk ^ (j1 & 15)) + 8 * (p4 & 1));
                    const bf16x8 ka = cat8(a0, a1);
#pragma unroll
                    for (int et = 0; et < 2; ++et) S[dt][et] = mfma16(ka, vb[et], S[dt][et]);
                }
            }
        }
        {
            const int it = w >> 1, et = w & 1;
            f32x4 in = (f32x4){0.f, 0.f, 0.f, 0.f}, cr = in;
#pragma unroll
            for (int ks2 = 0; ks2 < 2; ++ks2) {
                const int i = 16 * it + c_;
                const bf16x8 pa = *(const LAS bf16x8*)(lds + R_PM + i * 128 + 16 * ((4 * ks2 + g) ^ (i & 7)));
                const int j0 = 32 * ks2 + 8 * g + q4;
                const s16x4 a0 = tr_read(lds + R_VS + j0 * 64 + (16 * et + 4 * p4) * 2), a1 = tr_read(lds + R_VS + (j0 + 4) * 64 + (16 * et + 4 * p4) * 2);
                in = mfma16(pa, cat8(a0, a1), in);
            }
#pragma unroll
            for (int ks = 0; ks < 8; ++ks) {
                const bf16x8 qa = *(const LAS bf16x8*)(lds + R_QS + (16 * it + c_) * 512 + 16 * ((4 * ks + g) ^ c_));
                const int e = 16 * et + c_;
                const bf16x8 sb = *(const LAS bf16x8*)(lds + R_ST + e * 512 + 16 * ((4 * ks + g) ^ (e & 15)));
                cr = mfma16(qa, sb, cr);
            }
#pragma unroll
            for (int j = 0; j < 4; ++j) {
                const int i = 16 * it + 4 * g + j;
                const float ov = in[j] + fast_exp2((float)(i + 1) * lg2) * cr[j];
                float sq = ov * ov;
                sq += __shfl_xor(sq, 1); sq += __shfl_xor(sq, 2); sq += __shfl_xor(sq, 4); sq += __shfl_xor(sq, 8);
                if (i < L) {
                    const int row = row0 + ci * 64 + i;
                    const unsigned pkd = cvt_pk_bf16(ov, 0.f);
                    Vr[(size_t)row * 2048 + h * 512 + sl * 32 + 16 * et + c_] = (bf16_t)(pkd & 0xffffu);
                    if (c_ == 0) rssp[((size_t)row * 4 + h) * 32 + sl * 2 + et] = sq;
                }
            }
        }
    };
    LDS_BARRIER();
    write_st();
    load_chunk(0, pqA, pkA, pvA, ppA);
    if (nch > 1) load_chunk(1, pqB, pkB, pvB, ppB);
    for (int ci = 0; ci < nch; ci += 2) {
        stage_chunk(pqA, pkA, pvA, ppA);
        LDS_BARRIER();
        if (ci + 2 < nch) load_chunk(ci + 2, pqA, pkA, pvA, ppA);
        compute_chunk(ci);
        LDS_BARRIER();
        write_st();
        if (ci + 1 < nch) {
            stage_chunk(pqB, pkB, pvB, ppB);
            LDS_BARRIER();
            if (ci + 3 < nch) load_chunk(ci + 3, pqB, pkB, pvB, ppB);
            compute_chunk(ci + 1);
            LDS_BARRIER();
            write_st();
        }
    }
#pragma unroll
    for (int dt = 0; dt < 2; ++dt)
#pragma unroll
        for (int et = 0; et < 2; ++et)
#pragma unroll
            for (int j = 0; j < 4; ++j) sout[(size_t)(32 * w + 16 * dt + 4 * g + j) * 512 + 16 * et + c_] = S[dt][et][j];
}

__global__ void __launch_bounds__(NTHREADS, 2) fwd_megakernel(Params P) {
    extern __shared__ __attribute__((aligned(16))) unsigned char lds_raw[];
    LAS unsigned char* lds = (LAS unsigned char*)lds_raw;
    cg::grid_group grid = cg::this_grid();
    unsigned char* ws = P.ws;
    const int G = gridDim.x, bid = blockIdx.x, tid = threadIdx.x;
    bf16_t* XB = (bf16_t*)(ws + WS_XB);
    u64* ss = (u64*)(ws + WS_SS);
    bf16_t* SCR = (bf16_t*)(ws + WS_SCR);
    bf16_t* H = SCR;

    unsigned* barctr = (unsigned*)(ws + WS_CTL) + 256; unsigned bartgt = 0;
#define GSYNC() gbar(barctr, bartgt, (unsigned)G, (volatile LAS unsigned*)(lds + LDS_MISC + 16))
    if (tid == 0) { ((volatile LAS unsigned*)(lds + LDS_MISC + 16))[0] = 0u; ((volatile LAS unsigned*)(lds + LDS_MISC + 16))[1] = 0u; }
    prep_phase(P, lds);
    grid.sync();
    if (tid == 0) gb_add(barctr + 544 + xcc_id());

#define ffn(f, ss_in, ss_out) do { \
        { pg8::Gemm g{XB, (const bf16_t*)(ws + WS_WGU + (f) * WGU_BYTES), MT, 5632, D}; pg8::StaticOrder S; S.init(MT, 5632, G, bid); \
          build_rtab(lds, S, ss + (size_t)(ss_in) * MT); \
          EpiGU E{(const LAS float*)(lds + LDS_RTAB), H}; pg8::gemm_phase<EpiGU>(lds, g, S, E); } \
        GSYNC(); \
        { pg8::Gemm g{H, (const bf16_t*)(ws + WS_WD + (f) * WD_BYTES), MP, D, DFF}; pg8::StaticOrder S; S.init(MP, D, G, bid); \
          EpiRes E{XB, ss + (size_t)(ss_out) * MT, 0.5f}; pg8::gemm_phase<EpiRes>(lds, g, S, E); \
          for (int tile = bid; tile < 256; tile += G) small_gemm_res<DFF>(H, (const bf16_t*)(ws + WS_WD + (f) * WD_BYTES), XB, ss + (size_t)(ss_out) * MT, 0.5f, lds, tile); } \
        GSYNC(); } while (0)

    ffn(0, 0, 1);
    {
        pg8::Gemm g{XB, (const bf16_t*)(ws + WS_WQKV), MT, 3072, D}; pg8::StaticOrder S; S.init(MT, 3072, G, bid);
        build_rtab(lds, S, ss + 1ull * MT);
        EpiQKV E{(const LAS float*)(lds + LDS_RTAB), SCR, P.out};
        pg8::gemm_phase<EpiQKV>(lds, g, S, E);
    }
    GSYNC();
    attn_phase(P, lds);
    GSYNC();
    {
        pg8::Gemm g{SCR + 3ull * MT * D, (const bf16_t*)(ws + WS_WO), MP, D, D}; pg8::StaticOrder S; S.init(MP, D, G, bid);
        EpiRes E{XB, ss + 2ull * MT, 1.0f};
        pg8::gemm_phase<EpiRes>(lds, g, S, E);
        for (int tile = bid; tile < 256; tile += G) small_gemm_res<D>(SCR + 3ull * MT * D, (const bf16_t*)(ws + WS_WO), XB, ss + 2ull * MT, 1.0f, lds, tile);
    }
    GSYNC();
    ffn(1, 2, 3);
    ffn(2, 3, 4);
    {
        pg8::Gemm g{XB, (const bf16_t*)(ws + WS_WRIN), MT, 6144, D}; pg8::StaticOrder S; S.init(MT, 6144, G, bid);
        build_rtab(lds, S, ss + 4ull * MT);
        EpiRetIn E{(const LAS float*)(lds + LDS_RTAB), SCR, SCR + (size_t)MT * D, SCR + 2ull * MT * D, SCR + 4ull * MT * D};
        pg8::gemm_phase<EpiRetIn>(lds, g, S, E);
    }
    GSYNC();
    for (int it0 = bid; it0 < RETP_ITEMS; it0 += G) retp_item(P, lds, it0);
    GSYNC();
    for (int it0 = bid; it0 < RET_ITEMS; it0 += G) {
        int item = it0;
        if (G == 256 && it0 < 256) { const int xcd = it0 & 7, j = it0 >> 3; item = (xcd * 2 + (j >> 4)) * 16 + (j & 15); }
        ret_item(P, lds, item);
    }
    GSYNC();
    {
        bf16_t* Vr = SCR + 2ull * MT * D; const bf16_t* Gr = SCR + 4ull * MT * D; const float* rssp = (const float*)(ws + WS_RSSP);
        const size_t npieces = (size_t)MT * 256;
        for (size_t p = (size_t)bid * NTHREADS + tid; p < npieces; p += (size_t)G * NTHREADS) {
            const size_t row = p >> 8; const int c8 = (int)(p & 255) * 8, hh = c8 >> 9;
            float tot = 0.f;
            {
                const f32x4* pp4 = (const f32x4*)(rssp + (row * 4 + hh) * 32);
#pragma unroll
                for (int q = 0; q < 8; ++q) { const f32x4 t4 = pp4[q]; tot += (t4[0] + t4[1]) + (t4[2] + t4[3]); }
            }
            const float r = rsqrtf(tot * (1.0f / 512.0f) + 1e-6f);
            const u32x4 ov = *(const u32x4*)(Vr + row * 2048 + c8), gv = *(const u32x4*)(Gr + row * 2048 + c8);
            u32x4 y;
            y.x = cvt_pk_bf16(bf16lo(ov.x) * bf16lo(gv.x) * r, bf16hi(ov.x) * bf16hi(gv.x) * r);
            y.y = cvt_pk_bf16(bf16lo(ov.y) * bf16lo(gv.y) * r, bf16hi(ov.y) * bf16hi(gv.y) * r);
            y.z = cvt_pk_bf16(bf16lo(ov.z) * bf16lo(gv.z) * r, bf16hi(ov.z) * bf16hi(gv.z) * r);
            y.w = cvt_pk_bf16(bf16lo(ov.w) * bf16lo(gv.w) * r, bf16hi(ov.w) * bf16hi(gv.w) * r);
            *(u32x4*)(Vr + row * 2048 + c8) = y;
        }
    }
    GSYNC();
    {
        pg8::Gemm g{SCR + 2ull * MT * D, (const bf16_t*)(ws + WS_WRO), MP, D, 2048}; pg8::StaticOrder S; S.init(MP, D, G, bid);
        EpiRes E{XB, ss + 5ull * MT, 1.0f};
        pg8::gemm_phase<EpiRes>(lds, g, S, E);
        for (int tile = bid; tile < 256; tile += G) small_gemm_res<2048>(SCR + 2ull * MT * D, (const bf16_t*)(ws + WS_WRO), XB, ss + 5ull * MT, 1.0f, lds, tile);
    }
    GSYNC();
    ffn(3, 5, 6);
    {
        const float* fg = P.in[23]; const u64* ssf = ss + 6ull * MT;
        const size_t npieces = (size_t)MT * 256;
        for (size_t p = (size_t)bid * NTHREADS + tid; p < npieces; p += (size_t)G * NTHREADS) {
            const size_t row = p >> 8; const int c4 = (int)(p & 255) * 4;
            const float r = rsqrtf((float)ssf[row] * (SS_INV / 1024.0f) + 1e-6f);
            const u32x2 xb = *(const u32x2*)(XB + row * D + c4);
            const f32x4 x = (f32x4){bf16lo(xb.x), bf16hi(xb.x), bf16lo(xb.y), bf16hi(xb.y)}, gn = *(const f32x4*)(fg + c4);
            float* dst = row < MP ? P.out + row * D + c4 : P.out + 16777216 + (row - MP) * D + c4;
            *(f32x4*)dst = x * r * gn;
        }
    }
}

extern "C" void kernel_launch(void* const* d_in, const int* in_sizes, int n_in, void* d_out, int out_size, void* d_ws, size_t ws_size, hipStream_t stream) {
    static int grid_blocks = 0;
    if (!grid_blocks) {
        if (n_in != 24 || ws_size < WS_END) { fprintf(stderr, "kernel_launch: unexpected n_in %d or ws_size %zu (< %zu)\n", n_in, ws_size, (size_t)WS_END); grid_blocks = -1; return; }
        int dev = 0, cus = 0, per_cu = 0;
        hipGetDevice(&dev);
        hipDeviceGetAttribute(&cus, hipDeviceAttributeMultiprocessorCount, dev);
        hipFuncSetAttribute((const void*)fwd_megakernel, hipFuncAttributeMaxDynamicSharedMemorySize, LDS_BYTES);
        hipOccupancyMaxActiveBlocksPerMultiprocessor(&per_cu, (const void*)fwd_megakernel, NTHREADS, LDS_BYTES);
        if (per_cu < 1) per_cu = 1;
        grid_blocks = cus * per_cu;
    }
    if (grid_blocks < 0) return;
    Params p{};
    for (int i = 0; i < 24; ++i) p.in[i] = (const float*)d_in[i];
    p.out = (float*)d_out; p.ws = (unsigned char*)d_ws;
    void* args[] = {&p};
    hipError_t e = hipLaunchCooperativeKernel((const void*)fwd_megakernel, dim3(grid_blocks), dim3(NTHREADS), args, LDS_BYTES, stream);
    if (e != hipSuccess) fprintf(stderr, "cooperative launch failed: %s (grid %d)\n", hipGetErrorString(e), grid_blocks);
}
```
